# Optimizing an MI355X kernel written in HIP

```python
import jax, jax.numpy as jnp
from jax import lax
import numpy as np

D_MODEL = 1024
BATCH = 8
SEQ = 4096
DEPTH = 2

ATTN_HEAD_DIM = 64
ATTN_GROUPS = ((128, 1), (512, 4), (2048, 16))
ATTN_HEADS_PER_GROUP = 4
ATTN_HEADS = ATTN_HEADS_PER_GROUP * len(ATTN_GROUPS)
ATTN_WIDTH = ATTN_HEADS * ATTN_HEAD_DIM
ATTN_OUT_WIDTH = ATTN_HEADS_PER_GROUP * ATTN_HEAD_DIM
BAND_BLOCK = 128
CONV_WIDTH = 3 * D_MODEL // 4
CONV_K = 3
HGRN_HEAD_DIM = 128
HGRN_WIDTH = 3 * D_MODEL // 4
HGRN_HEADS = HGRN_WIDTH // HGRN_HEAD_DIM
HGRN_CHUNK = 64
LB_FLOOR = 1e-30
N_BRANCHES = 3
SPLIT_SIZES = (ATTN_WIDTH,) * 3 + (CONV_WIDTH,) * 3 + (HGRN_WIDTH,) * 4 + (D_MODEL,) * N_BRANCHES
IN_COLS = sum(SPLIT_SIZES)
D_FF_DENSE = 2816
N_EXPERTS = 8
TOP_K = 2
D_FF_EXPERT = 3584
N_DENSE = (DEPTH + 1) // 2
N_MOE = DEPTH // 2
RMS_EPS = 1e-6
NEG_BIG = -1e30

kernel_name = "hybrid_dilated_attn_shortconv_hgrn2_moe"


def _rmsnorm(x, gain):
    xf = x.astype(jnp.float32)
    y = xf * lax.rsqrt(jnp.mean(xf * xf, axis=-1, keepdims=True) + RMS_EPS)
    return (y * gain).astype(x.dtype)


def _swiglu(h, w1, w3, w2):
    return (jax.nn.silu(h @ w1) * (h @ w3)) @ w2


def _to_residue(t, d):
    B, S = t.shape[:2]
    t = t.reshape((B, S // d, d) + t.shape[2:])
    t = jnp.moveaxis(t, 2, 1)
    return t.reshape((B * d, S // d) + t.shape[3:])


def _from_residue(t, d, B):
    L = t.shape[1]
    t = t.reshape((B, d, L) + t.shape[2:])
    t = jnp.moveaxis(t, 1, 2)
    return t.reshape((B, L * d) + t.shape[3:])


def _banded_window_attention(q, k, v, win):
    N, L, H, E = q.shape
    nb = -(-L // BAND_BLOCK)
    pad_end = nb * BAND_BLOCK - L
    qb = jnp.pad(q, ((0, 0), (0, pad_end), (0, 0), (0, 0))).reshape(N, nb, BAND_BLOCK, H, E)

    def kv_blocks(t):
        tp = jnp.pad(t, ((0, 0), (BAND_BLOCK, pad_end), (0, 0), (0, 0)))
        tp = tp.reshape(N, nb + 1, BAND_BLOCK, H, E)
        return jnp.concatenate([tp[:, :-1], tp[:, 1:]], axis=2)

    kb, vb = kv_blocks(k), kv_blocks(v)
    s = jnp.einsum('nbqhe,nbkhe->nbhqk', qb, kb).astype(jnp.float32) * (E ** -0.5)
    qi = jnp.arange(BAND_BLOCK)[:, None]
    kj = jnp.arange(2 * BAND_BLOCK)[None, :]
    rel = qi + BAND_BLOCK - kj
    key_abs = (jnp.arange(nb) * BAND_BLOCK - BAND_BLOCK)[:, None, None] + kj
    valid = (rel >= 0) & (rel <= win) & (key_abs >= 0)
    s = jnp.where(valid[None, :, None], s, NEG_BIG)
    m = jnp.max(s, axis=-1, keepdims=True)
    p = jnp.exp(s - m)
    den = jnp.sum(p, axis=-1)
    o = jnp.einsum('nbhqk,nbkhe->nbqhe', p, vb.astype(jnp.float32))
    o = o / jnp.transpose(den, (0, 1, 3, 2))[..., None]
    lse = jnp.transpose(m[..., 0] + jnp.log(den), (0, 1, 3, 2))
    o = o.reshape(N, nb * BAND_BLOCK, H, E)[:, :L]
    lse = lse.reshape(N, nb * BAND_BLOCK, H)[:, :L]
    return o, lse


def _dilated_attention(q, k, v, q_gain, k_gain):
    B, S, _ = q.shape
    shp = (B, S, ATTN_HEADS, ATTN_HEAD_DIM)
    q = _rmsnorm(q.reshape(shp), q_gain)
    k = _rmsnorm(k.reshape(shp), k_gain)
    v = v.reshape(shp)
    outs, lses = [], []
    for g, (window, dilation) in enumerate(ATTN_GROUPS):
        hs = slice(g * ATTN_HEADS_PER_GROUP, (g + 1) * ATTN_HEADS_PER_GROUP)
        o, lse = _banded_window_attention(_to_residue(q[:, :, hs], dilation),
                                          _to_residue(k[:, :, hs], dilation),
                                          _to_residue(v[:, :, hs], dilation),
                                          window // dilation)
        outs.append(_from_residue(o, dilation, B))
        lses.append(_from_residue(lse, dilation, B))
    o = jnp.stack(outs)
    w = jax.nn.softmax(jnp.stack(lses), axis=0)
    o = jnp.einsum('gbsh,gbshe->bshe', w, o)
    return o.reshape(B, S, ATTN_OUT_WIDTH).astype(q.dtype)


def _short_conv(xb, b_gate, c_gate, conv_w):
    u = c_gate * xb
    S = u.shape[1]
    up = jnp.pad(u, ((0, 0), (CONV_K - 1, 0), (0, 0)))
    y = conv_w[0] * up[:, CONV_K - 1:CONV_K - 1 + S]
    for j in range(1, CONV_K):
        y = y + conv_w[j] * up[:, CONV_K - 1 - j:CONV_K - 1 - j + S]
    return b_gate * y


def _hgrn2_chunked(q, k, log_f, v):
    B, S, H, K = q.shape
    V = v.shape[-1]
    nc = S // HGRN_CHUNK

    def chunks(t):
        t = t.astype(jnp.float32).reshape(B, nc, HGRN_CHUNK, H, t.shape[-1])
        return jnp.transpose(t, (1, 0, 3, 2, 4))

    causal = jnp.tril(jnp.ones((HGRN_CHUNK, HGRN_CHUNK), dtype=bool))[:, :, None]

    def step(state, xs):
        qc, kc, gc, vc = xs
        b = jnp.cumsum(gc, axis=2)
        diff = b[:, :, :, None, :] - b[:, :, None, :, :]
        decay = jnp.where(causal, jnp.exp(jnp.where(causal, diff, 0.0)), 0.0)
        scores = jnp.einsum('bhtk,bhsk,bhtsk->bhts', qc, kc, decay)
        o = scores @ vc + jnp.einsum('bhtk,bhkv->bhtv', qc * jnp.exp(b), state)
        b_last = b[:, :, -1:, :]
        state = (jnp.exp(b_last[:, :, 0, :])[..., None] * state
                 + jnp.einsum('bhsk,bhsv->bhkv', kc * jnp.exp(b_last - b), vc))
        return state, o

    state0 = jnp.zeros((B, H, K, V), jnp.float32)
    _, o = lax.scan(step, state0, (chunks(q), chunks(k), chunks(log_f), chunks(v)))
    return jnp.transpose(o, (1, 0, 3, 2, 4)).reshape(B, S, H, V)


def _hgrn2(q, f_logit, i, g, lb, out_gain):
    B, S, _ = q.shape
    shp = (B, S, HGRN_HEADS, HGRN_HEAD_DIM)
    qh = jax.nn.silu(q).reshape(shp)
    lbh = lb.reshape(HGRN_HEADS, HGRN_HEAD_DIM)
    log_f = jnp.logaddexp(jnp.log(jnp.maximum(lbh, LB_FLOOR)),
                          jnp.log1p(-lbh) + jax.nn.log_sigmoid(f_logit.astype(jnp.float32).reshape(shp)))
    k = -jnp.expm1(log_f)
    o = _hgrn2_chunked(qh, k, log_f, i.reshape(shp))
    o = _rmsnorm(o, out_gain) * jax.nn.silu(g.astype(jnp.float32).reshape(shp))
    return o.reshape(B, S, HGRN_WIDTH).astype(q.dtype)


def _moe(h, router_w, w1, w3, w2):
    logits = (h @ router_w).astype(jnp.float32)
    top_vals, top_idx = lax.top_k(logits, TOP_K)
    gates = jax.nn.softmax(top_vals, axis=-1)
    combine = jnp.sum(jax.nn.one_hot(top_idx, N_EXPERTS, dtype=jnp.float32) * gates[..., None], axis=-2)
    out = jnp.zeros_like(h)
    for e in range(N_EXPERTS):
        out = out + combine[..., e:e + 1].astype(h.dtype) * _swiglu(h, w1[e], w3[e], w2[e])
    return out


def setup_inputs(seed: int = 0) -> dict:
    key = jax.random.key(seed)
    ks = jax.random.split(key, 22)
    f32 = jnp.float32

    def nrm(k, shape, fan_in):
        return jax.random.normal(k, shape, f32) * (fan_in ** -0.5)

    def gain(k, shape):
        return 1.0 + 0.1 * jax.random.normal(k, shape, f32)

    return {
        "x": jax.random.normal(ks[0], (BATCH, SEQ, D_MODEL), f32),
        "attn_norm": gain(ks[1], (DEPTH, D_MODEL)),
        "ffn_norm": gain(ks[2], (DEPTH, D_MODEL)),
        "w_in": nrm(ks[3], (DEPTH, D_MODEL, IN_COLS), D_MODEL),
        "q_norm": gain(ks[4], (DEPTH, ATTN_HEAD_DIM)),
        "k_norm": gain(ks[5], (DEPTH, ATTN_HEAD_DIM)),
        "conv_w": nrm(ks[6], (DEPTH, CONV_K, CONV_WIDTH), CONV_K),
        "hgrn_lower_bounds": 0.5 * jax.random.normal(ks[7], (DEPTH, HGRN_WIDTH), f32),
        "hgrn_out_norm": gain(ks[8], (DEPTH, HGRN_HEAD_DIM)),
        "w_proj_a": nrm(ks[9], (DEPTH, ATTN_OUT_WIDTH, D_MODEL), ATTN_OUT_WIDTH),
        "w_proj_b": nrm(ks[10], (DEPTH, CONV_WIDTH, D_MODEL), CONV_WIDTH),
        "w_proj_c": nrm(ks[11], (DEPTH, HGRN_WIDTH, D_MODEL), HGRN_WIDTH),
        "w_out": nrm(ks[12], (DEPTH, D_MODEL, D_MODEL), D_MODEL),
        "dense_w1": nrm(ks[13], (N_DENSE, D_MODEL, D_FF_DENSE), D_MODEL),
        "dense_w3": nrm(ks[14], (N_DENSE, D_MODEL, D_FF_DENSE), D_MODEL),
        "dense_w2": nrm(ks[15], (N_DENSE, D_FF_DENSE, D_MODEL), D_FF_DENSE),
        "router_w": nrm(ks[16], (N_MOE, D_MODEL, N_EXPERTS), D_MODEL),
        "moe_w1": nrm(ks[17], (N_MOE, N_EXPERTS, D_MODEL, D_FF_EXPERT), D_MODEL),
        "moe_w3": nrm(ks[18], (N_MOE, N_EXPERTS, D_MODEL, D_FF_EXPERT), D_MODEL),
        "moe_w2": nrm(ks[19], (N_MOE, N_EXPERTS, D_FF_EXPERT, D_MODEL), D_FF_EXPERT),
    }


def reference(x, attn_norm, ffn_norm, w_in, q_norm, k_norm, conv_w, hgrn_lower_bounds,
              hgrn_out_norm, w_proj_a, w_proj_b, w_proj_c, w_out, dense_w1, dense_w3,
              dense_w2, router_w, moe_w1, moe_w3, moe_w2):
    split_points = [int(p) for p in np.cumsum(SPLIT_SIZES)[:-1]]
    lbs = jax.nn.softmax(hgrn_lower_bounds.astype(jnp.float32), axis=0)
    lower_bound = jnp.cumsum(lbs, axis=0) - lbs[0]
    for layer in range(DEPTH):
        h = _rmsnorm(x, attn_norm[layer])
        proj = h @ w_in[layer]
        (qa, ka, va, xb, bb, cb, qc, fc, ic, gc,
         gate_a, gate_b, gate_c) = jnp.split(proj, split_points, axis=-1)
        ya = _dilated_attention(qa, ka, va, q_norm[layer], k_norm[layer]) @ w_proj_a[layer]
        yb = _short_conv(xb, bb, cb, conv_w[layer]) @ w_proj_b[layer]
        yc = _hgrn2(qc, fc, ic, gc, lower_bound[layer], hgrn_out_norm[layer]) @ w_proj_c[layer]
        merged = (jax.nn.sigmoid(gate_a) * ya + jax.nn.sigmoid(gate_b) * yb
                  + jax.nn.sigmoid(gate_c) * yc)
        x = x + merged @ w_out[layer]
        h = _rmsnorm(x, ffn_norm[layer])
        if layer % 2 == 0:
            j = layer // 2
            x = x + _swiglu(h, dense_w1[j], dense_w3[j], dense_w2[j])
        else:
            j = layer // 2
            x = x + _moe(h, router_w[j], moe_w1[j], moe_w3[j], moe_w2[j])
    return x
```

```cpp
#include <hip/hip_runtime.h>
#include <cstdio>
#include <cstdint>

#ifndef MK_N_LAUNCHES
#define MK_N_LAUNCHES 1
#endif

namespace pg8 {
#define PG8_LAS __attribute__((address_space(3)))
typedef unsigned short bf16_t;
typedef short bf16x8 __attribute__((ext_vector_type(8)));
typedef float f32x4 __attribute__((ext_vector_type(4)));
typedef unsigned u32x4 __attribute__((ext_vector_type(4)));
typedef unsigned u32x2 __attribute__((ext_vector_type(2)));
typedef int v8i __attribute__((ext_vector_type(8)));
typedef int v4i __attribute__((ext_vector_type(4)));
template <bool FP8> struct Frag { bf16x8 k[2]; };
template <> struct Frag<true> { v8i v; };
constexpr int BM = 256, BK = 64, HALF = 128, HTB = HALF * BK * 2, STAGE_BYTES = 8 * HTB, NXCD = 8, WGM = 4;

__host__ __device__ __forceinline__ int lds_byte(int r, int c) { const int st = (r >> 4) * 2 + (c >> 5), rr = r & 15, cc = c & 31, ob = rr * 64 + cc * 2; return st * 1024 + (ob ^ (((ob >> 9) & 1) << 5)); }
__host__ __device__ __forceinline__ void stage_rc(int b, int& R, int& C) { const int st = b / 1024, sb = b % 1024, swz = sb ^ (((sb >> 9) & 1) << 5); R = (st >> 1) * 16 + swz / 64; C = (st & 1) * 32 + (swz % 64) / 2; }

__device__ __forceinline__ int lane_now() { int l; asm volatile("v_mbcnt_lo_u32_b32 %0, -1, 0\n\tv_mbcnt_hi_u32_b32 %0, -1, %0" : "=v"(l)); return l; }
struct Unit { int pm, pn, g; };

typedef float f32x2_t __attribute__((ext_vector_type(2))); typedef __bf16 bf16x2_t __attribute__((ext_vector_type(2)));
__device__ __forceinline__ unsigned cvt_pk_bf16(float lo, float hi) { f32x2_t v = {lo, hi}; bf16x2_t b = __builtin_convertvector(v, bf16x2_t); return __builtin_bit_cast(unsigned, b); }
__device__ __forceinline__ float bf_lo(unsigned u) { return __uint_as_float(u << 16); }
__device__ __forceinline__ float bf_hi(unsigned u) { return __uint_as_float(u & 0xffff0000u); }

__device__ __forceinline__ int xcd_remap(int L, int nwg) { const int q = nwg / NXCD, r = nwg % NXCD, xcd = L % NXCD, off = L / NXCD; return (xcd < r ? xcd * (q + 1) : r * (q + 1) + (xcd - r) * q) + off; }
__device__ __forceinline__ void tile_decode(int w, int nM, int nN, int& pm, int& pn) { const int nig = WGM * nN, gid = w / nig, fm = gid * WGM, gsz = (nM - fm) < WGM ? (nM - fm) : WGM; pm = fm + ((w % nig) % gsz); pn = (w % nig) / gsz; }

struct StaticOrder {
    static constexpr bool GATHER = false;
    const char* A; const char* Bt; int nM, nN, nwg, G, c;
    __device__ __forceinline__ void init(const void* A_, const void* Bt_, int M, int N, int G_, int c_) { A = (const char*)A_; Bt = (const char*)Bt_; nM = M / BM; nN = N / BM; nwg = nM * nN; G = G_; c = c_; }
    __device__ __forceinline__ bool next(int i, Unit& u) const { const long L = (long)i * G + c; if (L >= nwg) return false; const int w = xcd_remap((int)L, nwg); tile_decode(w, nM, nN, u.pm, u.pn); u.g = 0; return true; }
    __device__ __forceinline__ const char* abase(const Unit& u, size_t tstep) const { return A + (size_t)u.pm * tstep; }
    __device__ __forceinline__ const char* bbase(const Unit& u, size_t tstep) const { return Bt + (size_t)u.pn * tstep; }
    __device__ __forceinline__ void avoff(const Unit&, int, int, unsigned (&)[2][2]) const {}
};

struct GateOrder {
    static constexpr bool GATHER = false;
    StaticOrder mo; const char* A; const char* Bt;
    __device__ __forceinline__ bool next(int i, Unit& u) const { Unit mu; if (!mo.next(i / 3, mu)) return false; u.pm = mu.pm; u.pn = 4 * (i % 3) + mu.pn; u.g = 0; return true; }
    __device__ __forceinline__ const char* abase(const Unit& u, size_t tstep) const { return A + (size_t)u.pm * tstep; }
    __device__ __forceinline__ const char* bbase(const Unit& u, size_t tstep) const { return Bt + (size_t)u.pn * tstep; }
    __device__ __forceinline__ void avoff(const Unit&, int, int, unsigned (&)[2][2]) const {}
};
template <int K, class Epi, class Sched, int LD = K, bool FP8 = false>
__device__ __forceinline__ void gemm_phase(PG8_LAS unsigned char* lds, const Sched& S, const Epi& E, const int wid) {
    constexpr bool GATHER = Sched::GATHER;
    int lane; asm volatile("v_mbcnt_lo_u32_b32 %0, -1, 0\n\tv_mbcnt_hi_u32_b32 %0, -1, %0" : "=v"(lane));
    const int tid = wid * 64 + lane, wr = wid >> 2, wc = wid & 3, fr = lane & 15, fq = lane >> 4;
    constexpr int EB = FP8 ? 1 : 2, nt = K * EB / 128;
    unsigned voffB[2]; unsigned vA[2][2];
#pragma unroll
    for (int i = 0; i < 2; ++i) { int R, C; stage_rc(tid * 16 + i * 8192, R, C); voffB[i] = (unsigned)(R * LD * EB + C * 2); vA[0][i] = voffB[i]; vA[1][i] = voffB[i]; }
    constexpr size_t kstep = (size_t)(BK * 2);
    constexpr size_t hstep = (size_t)HALF * LD * EB;
    constexpr size_t tstep = 2 * hstep;
    const unsigned ldsw = (unsigned)wid * 1024u;
    const int fcol = fq * 8;
    const int aoff = lds_byte(wr * 64 + fr, fcol), boff = lds_byte(wc * 32 + fr, fcol);
#define PG8_SA(b, h) (((b) * 2 + (h)) * HTB)
#define PG8_SB(b, h) ((4 + (b) * 2 + (h)) * HTB)
#define PG8_STAGE(bufoff, gbase, voff) do { _Pragma("unroll") for (int _i = 0; _i < 2; ++_i) \
        __builtin_amdgcn_global_load_lds((const unsigned*)((const char*)(gbase) + (voff)[_i]), (PG8_LAS unsigned*)(lds + (bufoff) + ldsw + _i * 8192), 16, 0, 0); } while (0)
#define PG8_STAGE_B(bufoff, gbase, h) PG8_STAGE(bufoff, (gbase) + (h) * hstep, voffB)
#define PG8_STAGE_A(bufoff, gbase, h) do { if constexpr (GATHER) { PG8_STAGE(bufoff, gbase, vA[h]); } else { PG8_STAGE(bufoff, (gbase) + (h) * hstep, vA[0]); } } while (0)
#define PG8_LDF(dst, p_) do { if constexpr (FP8) { const v4i lo_ = *(const PG8_LAS v4i*)(p_), hi_ = *(const PG8_LAS v4i*)((p_) + 1024); dst.v = __builtin_shufflevector(lo_, hi_, 0, 1, 2, 3, 4, 5, 6, 7); } \
        else { dst.k[0] = *(const PG8_LAS bf16x8*)(p_); dst.k[1] = *(const PG8_LAS bf16x8*)((p_) + 1024); } } while (0)
#define PG8_LDA(dst, b, h) do { _Pragma("unroll") for (int m = 0; m < 4; ++m) PG8_LDF(dst[m], lds + PG8_SA(b, h) + aoff + m * 2048); } while (0)
#define PG8_LDB(dst, b, h) do { _Pragma("unroll") for (int n = 0; n < 2; ++n) PG8_LDF(dst[n], lds + PG8_SB(b, h) + boff + n * 2048); } while (0)
#define PG8_MMA(ai, bj, At, Bt) do { __builtin_amdgcn_s_setprio(1); _Pragma("unroll") for (int m = 0; m < 4; ++m) _Pragma("unroll") for (int n = 0; n < 2; ++n) { \
        if constexpr (FP8) asm volatile("v_mfma_scale_f32_16x16x128_f8f6f4 %0, %1, %2, %0, %3, %3 op_sel_hi:[0,0,0]" : "+v"(acc[ai][bj][m][n]) : "v"(Bt[n].v), "v"(At[m].v), "v"(0x7f7f7f7f));   \
        else { _Pragma("unroll") for (int k = 0; k < 2; ++k) acc[ai][bj][m][n] = __builtin_amdgcn_mfma_f32_16x16x32_bf16(Bt[n].k[k], At[m].k[k], acc[ai][bj][m][n], 0, 0, 0); } } \
        __builtin_amdgcn_s_setprio(0); } while (0)
#define PG8_WAIT_V(n) asm volatile("s_waitcnt vmcnt(" #n ")" ::: "memory")
#define PG8_WAIT_L(n) asm volatile("s_waitcnt lgkmcnt(" #n ")" ::: "memory")
#define PG8_BAR __builtin_amdgcn_s_barrier()
#define PG8_SCHED __builtin_amdgcn_sched_barrier(0)
    Unit cur, nxt; int ui = 0;
    if (!S.next(0, cur)) return;
    f32x4 acc[2][2][4][2];
#pragma unroll
    for (int a = 0; a < 2; ++a)
#pragma unroll
        for (int b = 0; b < 2; ++b)
#pragma unroll
            for (int m = 0; m < 4; ++m)
#pragma unroll
                for (int n = 0; n < 2; ++n) acc[a][b][m][n] = (f32x4){0.f, 0.f, 0.f, 0.f};
    Frag<FP8> At[4], B0[2], B1[2];
    const char* cA = S.abase(cur, tstep); const char* cB = S.bbase(cur, tstep);
    if constexpr (GATHER) S.avoff(cur, wid, LD * EB, vA);
    PG8_STAGE_B(PG8_SB(0, 0), cB, 0); PG8_STAGE_B(PG8_SB(0, 1), cB, 1); PG8_STAGE_A(PG8_SA(0, 0), cA, 0); PG8_STAGE_A(PG8_SA(0, 1), cA, 1);
    if (wr == 1) PG8_BAR;
    PG8_WAIT_V(2); PG8_BAR;
    PG8_STAGE_B(PG8_SB(1, 0), cB + kstep, 0); PG8_STAGE_A(PG8_SA(1, 0), cA + kstep, 0); PG8_STAGE_B(PG8_SB(1, 1), cB + kstep, 1);
    PG8_WAIT_V(6); PG8_BAR;
    for (;;) {
        const bool has_next = S.next(ui + 1, nxt);
        const char* nA = has_next ? S.abase(nxt, tstep) : cA; const char* nB = has_next ? S.bbase(nxt, tstep) : cB;
#pragma unroll 1
        for (int t = 0; t < nt; t += 2) {
            const bool last = (t == nt - 2);
            if constexpr (Epi::MID) { if (E.is_mid(t)) { PG8_SCHED; E.mid(acc, cur, t, wr, wc, fr, fq); PG8_SCHED; } }
            const char* a1 = cA + (size_t)(t + 1) * kstep;
            const char* a2 = last ? nA : cA + (size_t)(t + 2) * kstep; const char* b2 = last ? nB : cB + (size_t)(t + 2) * kstep;
            const char* a3 = a2 + kstep; const char* b3 = b2 + kstep;
            PG8_LDB(B0, 0, 0); PG8_LDB(B1, 0, 1); PG8_SCHED; PG8_LDA(At, 0, 0); PG8_STAGE_A(PG8_SA(1, 1), a1, 1);
            PG8_WAIT_V(8); PG8_WAIT_L(0); PG8_BAR; PG8_MMA(0, 0, At, B0); PG8_MMA(0, 1, At, B1); PG8_BAR; PG8_SCHED;
            if constexpr (GATHER) { if (last && has_next) S.avoff(nxt, wid, LD * EB, vA); }
            PG8_LDA(At, 0, 1); PG8_STAGE_B(PG8_SB(0, 0), b2, 0); PG8_STAGE_B(PG8_SB(0, 1), b2, 1); PG8_STAGE_A(PG8_SA(0, 0), a2, 0);
            PG8_WAIT_V(8); PG8_WAIT_L(0); PG8_BAR; PG8_MMA(1, 0, At, B0); PG8_MMA(1, 1, At, B1); PG8_BAR; PG8_SCHED;
            PG8_LDB(B0, 1, 0); PG8_LDB(B1, 1, 1); PG8_SCHED; PG8_LDA(At, 1, 0); PG8_STAGE_A(PG8_SA(0, 1), a2, 1);
            PG8_WAIT_V(8); PG8_WAIT_L(0); PG8_BAR; PG8_MMA(0, 0, At, B0); PG8_MMA(0, 1, At, B1); PG8_BAR; PG8_SCHED;
            PG8_LDA(At, 1, 1); PG8_STAGE_B(PG8_SB(1, 0), b3, 0); PG8_STAGE_B(PG8_SB(1, 1), b3, 1); PG8_STAGE_A(PG8_SA(1, 0), a3, 0);
            PG8_WAIT_V(8); PG8_WAIT_L(0); PG8_BAR; PG8_MMA(1, 0, At, B0); PG8_MMA(1, 1, At, B1); PG8_BAR; PG8_SCHED;
        }
        if (wr == 0) PG8_BAR;
        if constexpr (FP8) asm volatile("s_nop 15\n\ts_nop 15" ::: "memory");
        E(acc, cur, wr, wc, fr, fq);
        if (!has_next) break;
#pragma unroll
        for (int a = 0; a < 2; ++a)
#pragma unroll
            for (int b = 0; b < 2; ++b)
#pragma unroll
                for (int m = 0; m < 4; ++m)
#pragma unroll
                    for (int n = 0; n < 2; ++n) acc[a][b][m][n] = (f32x4){0.f, 0.f, 0.f, 0.f};
        cur = nxt; cA = nA; cB = nB; ++ui;
        if (wr == 1) PG8_BAR;
    }
    PG8_WAIT_V(0);
    PG8_BAR;
#undef PG8_SA
#undef PG8_SB
#undef PG8_STAGE
#undef PG8_STAGE_A
#undef PG8_STAGE_B
#undef PG8_LDA
#undef PG8_LDF
#undef PG8_LDB
#undef PG8_MMA
#undef PG8_WAIT_V
#undef PG8_WAIT_L
#undef PG8_BAR
#undef PG8_SCHED
}
}

constexpr int NWAVES = 8, NTHR = 512;
constexpr int BATCH = 8, SEQ = 4096, DM = 1024, M = BATCH * SEQ;
constexpr int INCOLS = 10752, NA = 4608, NC = 3072, NG = 3072, KP = 1792;
constexpr int NAO = 3840;
constexpr int FFD = 2816, FFE = 3584, NEXP = 8;
constexpr int HG_H = 6, HG_D = 128, HSEG = 16, HSEGLEN = SEQ / HSEG;
constexpr float RMS_EPS = 1e-6f;
constexpr float QSCALE = 0.125f * 1.4426950408889634f;

constexpr size_t MiB = 1u << 20;
constexpr size_t WS_CTL = 0, CTL_ZERO_BYTES = 1 * MiB;
constexpr size_t WS_MISC = 1 * MiB;
constexpr size_t WS_W = 2 * MiB;
constexpr size_t SZ_WA = (size_t)NA * DM * 2, SZ_WC = (size_t)NC * DM * 2, SZ_WG = (size_t)NG * DM * 2, SZ_WP = (size_t)DM * KP * 2, SZ_WO = (size_t)DM * DM * 2;
constexpr size_t SZ_WL = SZ_WA + SZ_WC + SZ_WG + SZ_WP + SZ_WO;
constexpr size_t OFF_WA = 0, OFF_WC = SZ_WA, OFF_WG = OFF_WC + SZ_WC, OFF_WP = OFF_WG + SZ_WG, OFF_WO = OFF_WP + SZ_WP;
constexpr size_t WS_W13 = WS_W + 2 * SZ_WL, SZ_W13 = (size_t)2 * FFD * DM * 2, WS_W2 = WS_W13 + SZ_W13, SZ_W2 = (size_t)DM * FFD * 2;
constexpr size_t WS_X16 = 72 * MiB;
static_assert(WS_W2 + SZ_W2 <= WS_X16, "weights fit");
constexpr size_t WS_R = 136 * MiB;
constexpr size_t R_BUFA = WS_R, R_MIX = WS_R + 288 * MiB, R_MERGED = WS_R + 400 * MiB, WS_END = WS_R + 464 * MiB;
constexpr size_t R_HG = R_BUFA, R_OLOC = R_BUFA + 192 * MiB, R_QD = R_BUFA + 240 * MiB;
constexpr size_t R_FST = R_MERGED, R_DST = R_MERGED + 48 * MiB;
constexpr size_t R_GATES = R_BUFA;
constexpr size_t R_HID = WS_R;
constexpr size_t R_W13E = WS_R, SZ_W13E = (size_t)2 * FFE * DM, R_W2E = WS_R + 56 * MiB, SZ_W2E = (size_t)DM * FFE;
constexpr size_t R_HIDE = WS_R + 84 * MiB;
constexpr float SW1 = 64.f, SW2 = 128.f, SH = 8.f;
constexpr size_t R_X8 = WS_R + 336 * MiB;
constexpr int MOE_MAXROWS = M + NEXP * 256;
constexpr size_t R_LIST = WS_R + 328 * MiB;
static_assert(R_HIDE + 2 * (size_t)MOE_MAXROWS * FFE <= R_LIST && R_LIST + 3 * 16 * (size_t)M * 4 <= R_X8 && R_X8 + (size_t)M * DM <= WS_END, "moe map");
constexpr int MI_RGW = 0;
constexpr int MI_LBA = 8192;
constexpr int CW_TMO = 0, CW_CODE = 1, CW_BAR = 4096, CW_CNT = 8192  ;
constexpr size_t WS_SSQ = WS_END, SZ_SSQ = (size_t)M * 16, WS_TOTAL = WS_SSQ + 3 * SZ_SSQ;

constexpr int RING_OFF = 0, RING_BYTES = 131072;
constexpr int LDSCTL_OFF = RING_BYTES, MISC_OFF = LDSCTL_OFF + 320;
constexpr int XCH_OFF = RING_BYTES + 1024;
constexpr int LDS_BYTES = 147456;

#define GAS __attribute__((address_space(1)))
#define LAS __attribute__((address_space(3)))
typedef unsigned short bf16;
typedef unsigned v4u __attribute__((ext_vector_type(4)));
typedef unsigned v2u __attribute__((ext_vector_type(2)));
typedef float f32x4 __attribute__((ext_vector_type(4)));
typedef GAS unsigned gu32;
#define RLX_AGENT __ATOMIC_RELAXED, __HIP_MEMORY_SCOPE_AGENT
#define LDS_WAIT() asm volatile("s_waitcnt lgkmcnt(0)" ::: "memory")
#define VM_WAIT() asm volatile("s_waitcnt vmcnt(0)" ::: "memory")
__device__ __forceinline__ unsigned f2bf(float f) { unsigned u = __builtin_bit_cast(unsigned, f); return (u + 0x7fffu + ((u >> 16) & 1u)) >> 16; }
__device__ __forceinline__ unsigned pk2(float lo, float hi) { return f2bf(lo) | (f2bf(hi) << 16); }
__device__ __forceinline__ float bflo(unsigned u) { return __uint_as_float(u << 16); }
__device__ __forceinline__ float bfhi(unsigned u) { return __uint_as_float(u & 0xffff0000u); }
__device__ __forceinline__ unsigned pk4_fp8(float a, float b, float c, float d) {
    a = __builtin_amdgcn_fmed3f(a, -448.f, 448.f); b = __builtin_amdgcn_fmed3f(b, -448.f, 448.f); c = __builtin_amdgcn_fmed3f(c, -448.f, 448.f); d = __builtin_amdgcn_fmed3f(d, -448.f, 448.f);
    int w = __builtin_amdgcn_cvt_pk_fp8_f32(a, b, 0, false); w = __builtin_amdgcn_cvt_pk_fp8_f32(c, d, w, true); return (unsigned)w; }
__device__ __forceinline__ float fast_rcp(float x) { return __builtin_amdgcn_rcpf(x); }
__device__ __forceinline__ float fast_exp(float x) { return __builtin_amdgcn_exp2f(x * 1.4426950408889634f); }
__device__ __forceinline__ float fast_log(float x) { return __builtin_amdgcn_logf(x) * 0.6931471805599453f; }
__device__ __forceinline__ float sigmoid_f(float x) { return fast_rcp(1.f + fast_exp(-x)); }
__device__ __forceinline__ float silu_f(float x) { return x * sigmoid_f(x); }

#define XB_TMO      128
#define XB_XCNT(j)  (256  + 64 * (j))
#define XB_XSUB(j)  (1280 + 64 * (j))
#define XB_XGEN(j)  (2304 + 64 * (j))
#define XB_TOP      3328
#define XB_TOPGEN   3392
#define XCD_BAR_WORDS 3456
#define XB_SPIN_CAP (1u << 18)
__device__ __forceinline__ unsigned xb_ld(unsigned* p)              { return __hip_atomic_load(p, __ATOMIC_RELAXED, __HIP_MEMORY_SCOPE_AGENT); }
__device__ __forceinline__ unsigned xb_add(unsigned* p, unsigned v) { return __hip_atomic_fetch_add(p, v, __ATOMIC_RELAXED, __HIP_MEMORY_SCOPE_AGENT); }
__device__ __forceinline__ unsigned xb_xcc_id() { return (unsigned)__builtin_amdgcn_s_getreg((3 << 11) | 20) & 0xFu; }
#define XB_SPIN(cond, bar) do { unsigned _sp = 0; while (cond) { __builtin_amdgcn_s_sleep(1); \
    if ((++_sp & 255u) == 0u) { if (xb_ld(&(bar)[XB_TMO])) break; if (_sp > XB_SPIN_CAP) { atomicAdd(&(bar)[XB_TMO], 1u); break; } } } } while (0)
struct XcdBarrier { unsigned* bar; unsigned x; volatile LAS unsigned* st; };
__device__ __forceinline__ XcdBarrier xcd_barrier_post(unsigned* bar, volatile LAS unsigned* st) {
    XcdBarrier b; b.bar = bar; b.x = xb_xcc_id(); b.st = st;
    if (threadIdx.x == 0) (void)xb_add(&bar[XB_XCNT(b.x)], 1u);
    return b;
}
__device__ __forceinline__ void xcd_barrier_complete(unsigned* bar, unsigned x, unsigned& nloc, unsigned& nx) {
    const unsigned G = gridDim.x * gridDim.y * gridDim.z;
    unsigned sum, cnt, mine, sp = 0u;
    for (;;) {
        sum = 0u; cnt = 0u; mine = 0u;
#pragma unroll
        for (unsigned j = 0; j < 16; ++j) { const unsigned c = xb_ld(&bar[XB_XCNT(j)]); sum += c; cnt += (c > 0u) ? 1u : 0u; mine = (j == x) ? c : mine; }
        if (sum == G) break;
        __builtin_amdgcn_s_sleep(1);
        if ((++sp & 255u) == 0u) { if (xb_ld(&bar[XB_TMO])) break; if (sp > XB_SPIN_CAP) { atomicAdd(&bar[XB_TMO], 1u); break; } }
    }
    nloc = mine > 0u ? mine : 1u; nx = cnt > 0u ? cnt : 1u;
}
__device__ __forceinline__ void xcd_barrier(const XcdBarrier& b) {
    asm volatile("s_waitcnt vmcnt(0)" ::: "memory");
    __syncthreads();
    if (threadIdx.x == 0) {
        unsigned* bar = b.bar;
        __builtin_amdgcn_s_waitcnt(0);
        unsigned nloc = b.st[0], nx = b.st[1];
        if (nloc == 0u) { xcd_barrier_complete(bar, b.x, nloc, nx); b.st[0] = nloc; b.st[1] = nx; }
        const unsigned old = xb_add(&bar[XB_XSUB(b.x)], 1u);
        const unsigned gen = old / nloc;
        if (old + 1u == (gen + 1u) * nloc) {
            __builtin_amdgcn_fence(__ATOMIC_RELEASE, "agent");
            asm volatile("s_waitcnt vmcnt(0)" ::: "memory");
            const unsigned og = xb_add(&bar[XB_TOP], 1u);
            const unsigned tg = og / nx;
            if (og + 1u == (tg + 1u) * nx) xb_add(&bar[XB_TOPGEN], 1u);
            else XB_SPIN(xb_ld(&bar[XB_TOPGEN]) == tg, bar);
            __builtin_amdgcn_fence(__ATOMIC_ACQUIRE, "agent");
            xb_add(&bar[XB_XGEN(b.x)], 1u);
            asm volatile("s_waitcnt vmcnt(0)" ::: "memory");
        } else {
            XB_SPIN(xb_ld(&bar[XB_XGEN(b.x)]) == gen, bar);
            __builtin_amdgcn_fence(__ATOMIC_ACQUIRE, "agent");
            asm volatile("s_waitcnt vmcnt(0)" ::: "memory");
        }
    }
    __syncthreads();
}

struct Frame {
    LAS unsigned char* lds;
    volatile LAS unsigned* MISC;
    unsigned* ctl;
    unsigned char* ws;
    int tid, lane, wave, G, vcu;
    const float* const* in;
    float* out;
};
__device__ __forceinline__ float wave_sum(float v) {
#pragma unroll
    for (int o = 1; o < 64; o <<= 1) v += __shfl_xor(v, o);
    return v;
}

#define LAUNDER_V(x) asm volatile("" : "+v"(x))
#define LAUNDER_S(x) asm volatile("" : "+s"(x))
__device__ __forceinline__ Frame phase_frame(const Frame& G) { Frame F = G; asm volatile("v_mbcnt_lo_u32_b32 %0, -1, 0\n\tv_mbcnt_hi_u32_b32 %0, -1, %0" : "=v"(F.lane)); F.tid = F.wave * 64 + F.lane; LAUNDER_S(F.ws); F.ctl = (unsigned*)(F.ws + WS_CTL); return F; }
using pg8::Unit; using pg8::cvt_pk_bf16;
#define EPI_LANE const int ln_ = pg8::lane_now(); fr = ln_ & 15; fq = ln_ >> 4
#define EPI_ROWS(u) EPI_LANE; const int row0 = (u).pm * 256 + wr * 64 + fr
#define EPI_RS8(ssq4) float rs8[8]; { f32x4 pp_[8]; _Pragma("unroll") for (int it_ = 0; it_ < 8; ++it_) pp_[it_] = *(const GAS f32x4*)((ssq4) + (size_t)(row0 + (it_ >> 2) * 128 + (it_ & 3) * 16) * 4); \
    _Pragma("unroll") for (int it_ = 0; it_ < 8; ++it_) rs8[it_] = __builtin_amdgcn_rsqf(((pp_[it_][0] + pp_[it_][1]) + (pp_[it_][2] + pp_[it_][3])) * (1.f / DM) + RMS_EPS); }
#define EPI_FOR_AM _Pragma("unroll") for (int ai = 0; ai < 2; ++ai) _Pragma("unroll") for (int m = 0; m < 4; ++m, __builtin_amdgcn_sched_barrier(0))

__device__ __forceinline__ float row_rstd(const GAS float* ssq4, int row) { const f32x4 p = *(const GAS f32x4*)(ssq4 + (size_t)row * 4); return __builtin_amdgcn_rsqf(((p[0] + p[1]) + (p[2] + p[3])) * (1.f / DM) + RMS_EPS); }
struct EpiA {
    static constexpr bool MID = false;
    GAS bf16* O; const GAS float* ssq; const GAS float* qg; const GAS float* kg;
    __device__ __forceinline__ void operator()(const f32x4 (&acc)[2][2][4][2], const Unit& u, int wr, int wc, int fr, int fq) const {
        EPI_ROWS(u); EPI_RS8(ssq);
        if (u.pn < 6) {
            const int colb = u.pn * 256 + 64 * wc + 8 * fq;
            const GAS float* gs = u.pn < 3 ? qg : kg; const float sc = u.pn < 3 ? QSCALE : 1.f;
            f32x4 gv[2][2];
#pragma unroll
            for (int bj = 0; bj < 2; ++bj)
#pragma unroll
                for (int n = 0; n < 2; ++n) gv[bj][n] = *(const GAS f32x4*)(gs + 32 * bj + 8 * fq + 4 * n) * sc;
            EPI_FOR_AM { const int row = row0 + ai * 128 + m * 16; const float rs = rs8[ai * 4 + m];
                float s = 0.f;
#pragma unroll
                for (int bj = 0; bj < 2; ++bj)
#pragma unroll
                    for (int n = 0; n < 2; ++n) { const f32x4 x = acc[ai][bj][m][n]; s += (x[0] * x[0] + x[1] * x[1]) + (x[2] * x[2] + x[3] * x[3]); }
                s += __shfl_xor(s, 16); s += __shfl_xor(s, 32);
                const float f = rs * __builtin_amdgcn_rsqf(rs * rs * s * (1.f / 64.f) + RMS_EPS);
#pragma unroll
                for (int bj = 0; bj < 2; ++bj) { const f32x4 v0 = acc[ai][bj][m][0] * f * gv[bj][0], v1 = acc[ai][bj][m][1] * f * gv[bj][1];
                    v4u w; w.x = cvt_pk_bf16(v0[0], v0[1]); w.y = cvt_pk_bf16(v0[2], v0[3]); w.z = cvt_pk_bf16(v1[0], v1[1]); w.w = cvt_pk_bf16(v1[2], v1[3]);
                    *(GAS v4u*)(O + (size_t)row * NAO + colb + 32 * bj) = w; } }
        } else if (u.pn >= 9 && u.pn < 15) {
            const int colb = 2304 + (u.pn - 9) * 128 + 32 * wc + 8 * fq;
            EPI_FOR_AM { const int row = row0 + ai * 128 + m * 16; const float r2 = rs8[ai * 4 + m] * rs8[ai * 4 + m];
                const f32x4 v0 = acc[ai][0][m][0] * acc[ai][1][m][0] * r2, v1 = acc[ai][0][m][1] * acc[ai][1][m][1] * r2;
                v4u w; w.x = cvt_pk_bf16(v0[0], v0[1]); w.y = cvt_pk_bf16(v0[2], v0[3]); w.z = cvt_pk_bf16(v1[0], v1[1]); w.w = cvt_pk_bf16(v1[2], v1[3]);
                *(GAS v4u*)(O + (size_t)row * NAO + colb) = w; }
        } else {
            const int colb = (u.pn < 9 ? u.pn * 256 : 3072 + (u.pn - 15) * 256) + 64 * wc + 8 * fq;
            EPI_FOR_AM { const int row = row0 + ai * 128 + m * 16; const float rs = rs8[ai * 4 + m];
#pragma unroll
                for (int bj = 0; bj < 2; ++bj) { const f32x4 v0 = acc[ai][bj][m][0] * rs, v1 = acc[ai][bj][m][1] * rs;
                    v4u w; w.x = cvt_pk_bf16(v0[0], v0[1]); w.y = cvt_pk_bf16(v0[2], v0[3]); w.z = cvt_pk_bf16(v1[0], v1[1]); w.w = cvt_pk_bf16(v1[2], v1[3]);
                    *(GAS v4u*)(O + (size_t)row * NAO + colb + 32 * bj) = w; } }
        }
    }
};
struct EpiC {
    static constexpr bool MID = false;
    GAS bf16* O; const GAS float* ssq; const GAS float* lbt;
    __device__ __forceinline__ void operator()(const f32x4 (&acc)[2][2][4][2], const Unit& u, int wr, int wc, int fr, int fq) const {
        EPI_ROWS(u); const int colb = u.pn * 256 + 64 * wc + 8 * fq; const int kind = u.pn / 3; EPI_RS8(ssq);
        if (kind == 1) {
            f32x4 lb[2][2], ob[2][2];
#pragma unroll
            for (int bj = 0; bj < 2; ++bj)
#pragma unroll
                for (int n = 0; n < 2; ++n) { lb[bj][n] = *(const GAS f32x4*)(lbt + (colb - 768 + 32 * bj + 4 * n)); ob[bj][n] = 1.f - lb[bj][n]; }
            EPI_FOR_AM { const int row = row0 + ai * 128 + m * 16; const float k1 = rs8[ai * 4 + m] * 1.4426950408889634f;
#pragma unroll
                for (int bj = 0; bj < 2; ++bj) { f32x4 v[2];
#pragma unroll
                    for (int n = 0; n < 2; ++n) { const f32x4 t = acc[ai][bj][m][n] * k1; f32x4 ez, d, r, sg;
#pragma unroll
                        for (int e = 0; e < 4; ++e) ez[e] = __builtin_amdgcn_exp2f(-__builtin_fabsf(t[e]));
                        d = ez + 1.f;
#pragma unroll
                        for (int e = 0; e < 4; ++e) r[e] = __builtin_amdgcn_rcpf(d[e]);
#pragma unroll
                        for (int e = 0; e < 4; ++e) sg[e] = (t[e] >= 0.f) ? r[e] : ez[e] * r[e];
                        f32x4 wv = ob[bj][n] * sg + lb[bj][n];
#pragma unroll
                        for (int e = 0; e < 4; ++e) wv[e] = __builtin_amdgcn_logf(__builtin_fmaxf(wv[e], 1e-37f));
                        v[n] = wv * 0.6931471805599453f; }
                    v4u w; w.x = cvt_pk_bf16(v[0][0], v[0][1]); w.y = cvt_pk_bf16(v[0][2], v[0][3]); w.z = cvt_pk_bf16(v[1][0], v[1][1]); w.w = cvt_pk_bf16(v[1][2], v[1][3]);
                    *(GAS v4u*)(O + (size_t)row * NC + colb + 32 * bj) = w; } }
        } else if (kind == 2) {
            EPI_FOR_AM { const int row = row0 + ai * 128 + m * 16; const float rs = rs8[ai * 4 + m];
#pragma unroll
                for (int bj = 0; bj < 2; ++bj) { const f32x4 v0 = acc[ai][bj][m][0] * rs, v1 = acc[ai][bj][m][1] * rs;
                    v4u w; w.x = cvt_pk_bf16(v0[0], v0[1]); w.y = cvt_pk_bf16(v0[2], v0[3]); w.z = cvt_pk_bf16(v1[0], v1[1]); w.w = cvt_pk_bf16(v1[2], v1[3]);
                    *(GAS v4u*)(O + (size_t)row * NC + colb + 32 * bj) = w; } }
        } else {
            EPI_FOR_AM { const int row = row0 + ai * 128 + m * 16; const float rs = rs8[ai * 4 + m]; const float k1 = rs * -1.4426950408889634f;
#pragma unroll
                for (int bj = 0; bj < 2; ++bj) { f32x4 v[2];
#pragma unroll
                    for (int n = 0; n < 2; ++n) { const f32x4 a = acc[ai][bj][m][n]; const f32x4 t = a * k1; f32x4 d, r;
#pragma unroll
                        for (int e = 0; e < 4; ++e) d[e] = __builtin_amdgcn_exp2f(t[e]);
                        d += 1.f;
#pragma unroll
                        for (int e = 0; e < 4; ++e) r[e] = __builtin_amdgcn_rcpf(d[e]);
                        v[n] = (a * rs) * r; }
                    v4u w; w.x = cvt_pk_bf16(v[0][0], v[0][1]); w.y = cvt_pk_bf16(v[0][2], v[0][3]); w.z = cvt_pk_bf16(v[1][0], v[1][1]); w.w = cvt_pk_bf16(v[1][2], v[1][3]);
                    *(GAS v4u*)(O + (size_t)row * NC + colb + 32 * bj) = w; } }
        }
    }
};
__device__ __forceinline__ float ub0(unsigned x) { return (float)(x & 0xffu); }
__device__ __forceinline__ float ub1(unsigned x) { return (float)((x >> 8) & 0xffu); }
__device__ __forceinline__ float ub2(unsigned x) { return (float)((x >> 16) & 0xffu); }
__device__ __forceinline__ float ub3(unsigned x) { return (float)(x >> 24); }
struct EpiG {
    static constexpr bool MID = false;
    GAS unsigned char* O; const GAS float* ssq;
    __device__ __forceinline__ void operator()(const f32x4 (&acc)[2][2][4][2], const Unit& u, int wr, int wc, int fr, int fq) const {
        EPI_ROWS(u); const int colb = u.pn * 256 + 64 * wc + 8 * fq; EPI_RS8(ssq);
        EPI_FOR_AM { const int row = row0 + ai * 128 + m * 16; const float k1 = rs8[ai * 4 + m] * -1.4426950408889634f;
#pragma unroll
            for (int bj = 0; bj < 2; ++bj) { v2u w; w.x = 0u; w.y = 0u;
#pragma unroll
                for (int n = 0; n < 2; ++n) { const f32x4 t = acc[ai][bj][m][n] * k1; f32x4 d, r;
#pragma unroll
                    for (int e = 0; e < 4; ++e) d[e] = __builtin_amdgcn_exp2f(t[e]);
                    d += 1.f;
#pragma unroll
                    for (int e = 0; e < 4; ++e) r[e] = __builtin_amdgcn_rcpf(d[e]);
                    const f32x4 q = r * 254.f + 1.5f; unsigned pk = 0u;
                    pk = __builtin_amdgcn_cvt_pk_u8_f32(q[0], 0, pk); pk = __builtin_amdgcn_cvt_pk_u8_f32(q[1], 1, pk); pk = __builtin_amdgcn_cvt_pk_u8_f32(q[2], 2, pk); pk = __builtin_amdgcn_cvt_pk_u8_f32(q[3], 3, pk);
                    if (n == 0) w.x = pk; else w.y = pk; }
                *(GAS v2u*)(O + (size_t)row * NG + colb + 32 * bj) = w; } }
    }
};
struct EpiM {
    static constexpr bool MID = true;
    GAS bf16* O; const GAS unsigned char* Gt;
    __device__ __forceinline__ bool is_mid(int t) const { return t == 4 || t == 16; }
    __device__ __forceinline__ void mid(f32x4 (&acc)[2][2][4][2], const Unit& u, int t, int wr, int wc, int fr, int fq) const {
        EPI_ROWS(u); const int colb = u.pn * 256 + 64 * wc + 8 * fq; const int sel = (t == 4) ? 0 : 1024;
        const GAS unsigned char* gp0 = Gt + (size_t)row0 * NG + sel + colb;
        v2u ga[2][4][2], gb[2][4][2];
#pragma unroll
        for (int ai = 0; ai < 2; ++ai)
#pragma unroll
            for (int m = 0; m < 4; ++m)
#pragma unroll
                for (int bj = 0; bj < 2; ++bj) { const GAS unsigned char* gp = gp0 + (size_t)(ai * 128 + m * 16) * NG + 32 * bj; ga[ai][m][bj] = *(const GAS v2u*)gp; gb[ai][m][bj] = *(const GAS v2u*)(gp + 1024); }
#pragma unroll
        for (int ai = 0; ai < 2; ++ai) {
#pragma unroll
            for (int m = 0; m < 4; ++m)
#pragma unroll
                for (int bj = 0; bj < 2; ++bj) { const v2u a = ga[ai][m][bj], b = gb[ai][m][bj]; f32x4 r0, r1;
                    r0[0] = ub0(a.x) * fast_rcp(ub0(b.x)); r0[1] = ub1(a.x) * fast_rcp(ub1(b.x)); r0[2] = ub2(a.x) * fast_rcp(ub2(b.x)); r0[3] = ub3(a.x) * fast_rcp(ub3(b.x));
                    r1[0] = ub0(a.y) * fast_rcp(ub0(b.y)); r1[1] = ub1(a.y) * fast_rcp(ub1(b.y)); r1[2] = ub2(a.y) * fast_rcp(ub2(b.y)); r1[3] = ub3(a.y) * fast_rcp(ub3(b.y));
                    acc[ai][bj][m][0] *= r0; acc[ai][bj][m][1] *= r1; }
            __builtin_amdgcn_sched_barrier(0); }
    }
    __device__ __forceinline__ void operator()(const f32x4 (&acc)[2][2][4][2], const Unit& u, int wr, int wc, int fr, int fq) const {
        EPI_ROWS(u); const int colb = u.pn * 256 + 64 * wc + 8 * fq;
        v2u cg[8][2];
#pragma unroll
        for (int it = 0; it < 8; ++it)
#pragma unroll
            for (int bj = 0; bj < 2; ++bj) cg[it][bj] = *(const GAS v2u*)(Gt + (size_t)(row0 + (it >> 2) * 128 + (it & 3) * 16) * NG + 2048 + colb + 32 * bj);
        EPI_FOR_AM { const int row = row0 + ai * 128 + m * 16;
#pragma unroll
            for (int bj = 0; bj < 2; ++bj) { const v2u c = cg[ai * 4 + m][bj]; constexpr float k = 1.f / 255.f;
                const f32x4 v0 = acc[ai][bj][m][0] * ((f32x4){ub0(c.x), ub1(c.x), ub2(c.x), ub3(c.x)} * k), v1 = acc[ai][bj][m][1] * ((f32x4){ub0(c.y), ub1(c.y), ub2(c.y), ub3(c.y)} * k);
                v4u w; w.x = cvt_pk_bf16(v0[0], v0[1]); w.y = cvt_pk_bf16(v0[2], v0[3]); w.z = cvt_pk_bf16(v1[0], v1[1]); w.w = cvt_pk_bf16(v1[2], v1[3]);
                *(GAS v4u*)(O + (size_t)row * DM + colb + 32 * bj) = w; } }
    }
};
struct EpiO {
    static constexpr bool MID = false;
    GAS bf16* x16; GAS float* ssq4; LAS float* xch;
    __device__ __forceinline__ void operator()(const f32x4 (&acc)[2][2][4][2], const Unit& u, int wr, int wc, int fr, int fq) const {
        EPI_ROWS(u); const int colb = u.pn * 256 + 64 * wc + 8 * fq;
        v4u cb[2][4][2];
#pragma unroll
        for (int ai = 0; ai < 2; ++ai)
#pragma unroll
            for (int m = 0; m < 4; ++m)
#pragma unroll
                for (int bj = 0; bj < 2; ++bj) cb[ai][m][bj] = *(const GAS v4u*)(x16 + (size_t)(row0 + ai * 128 + m * 16) * DM + colb + 32 * bj);
#pragma unroll
        for (int ai = 0; ai < 2; ++ai) {
#pragma unroll
            for (int m = 0; m < 4; ++m) { const int row = row0 + ai * 128 + m * 16; f32x4 s4 = {0.f, 0.f, 0.f, 0.f};
#pragma unroll
                for (int bj = 0; bj < 2; ++bj) { const size_t off = (size_t)row * DM + colb + 32 * bj; const v4u c = cb[ai][m][bj];
                    const f32x4 v0 = (f32x4){bflo(c.x), bfhi(c.x), bflo(c.y), bfhi(c.y)} + acc[ai][bj][m][0], v1 = (f32x4){bflo(c.z), bfhi(c.z), bflo(c.w), bfhi(c.w)} + acc[ai][bj][m][1];
                    s4 += v0 * v0; s4 += v1 * v1;
                    v4u w; w.x = cvt_pk_bf16(v0[0], v0[1]); w.y = cvt_pk_bf16(v0[2], v0[3]); w.z = cvt_pk_bf16(v1[0], v1[1]); w.w = cvt_pk_bf16(v1[2], v1[3]);
                    *(GAS v4u*)(x16 + off) = w; }
                float s = (s4[0] + s4[1]) + (s4[2] + s4[3]);
                s += __shfl_xor(s, 16); s += __shfl_xor(s, 32);
                if (fq == 0) xch[(ai * 128 + wr * 64 + m * 16 + fr) * 4 + wc] = s; }
            __builtin_amdgcn_sched_barrier(0); }
        asm volatile("s_waitcnt lgkmcnt(0)" ::: "memory"); __builtin_amdgcn_s_barrier(); asm volatile("" ::: "memory");
        if (wr == 0) { const int r = wc * 64 + ln_; const f32x4 p = *(const LAS f32x4*)(xch + r * 4); ssq4[(size_t)(u.pm * 256 + r) * 4 + u.pn] = (p[0] + p[1]) + (p[2] + p[3]); }
    }
};
struct EpiU {
    static constexpr bool MID = false;
    GAS bf16* H; const GAS float* ssq;
    __device__ __forceinline__ void operator()(const f32x4 (&acc)[2][2][4][2], const Unit& u, int wr, int wc, int fr, int fq) const {
        EPI_ROWS(u); const int colb = u.pn * 128 + 32 * wc + 8 * fq; EPI_RS8(ssq);
        EPI_FOR_AM { const int row = row0 + ai * 128 + m * 16; const float rs = rs8[ai * 4 + m]; const float k1 = rs * -1.4426950408889634f, k2 = rs * rs;
            f32x4 h[2];
#pragma unroll
            for (int n = 0; n < 2; ++n) { const f32x4 a1 = acc[ai][0][m][n], a3 = acc[ai][1][m][n]; const f32x4 t = a1 * k1; f32x4 d, r;
#pragma unroll
                for (int e = 0; e < 4; ++e) d[e] = __builtin_amdgcn_exp2f(t[e]);
                d += 1.f;
#pragma unroll
                for (int e = 0; e < 4; ++e) r[e] = __builtin_amdgcn_rcpf(d[e]);
                h[n] = ((a1 * k2) * a3) * r; }
            v4u w; w.x = cvt_pk_bf16(h[0][0], h[0][1]); w.y = cvt_pk_bf16(h[0][2], h[0][3]); w.z = cvt_pk_bf16(h[1][0], h[1][1]); w.w = cvt_pk_bf16(h[1][2], h[1][3]);
            *(GAS v4u*)(H + (size_t)row * FFD + colb) = w; }
    }
};

struct MoeOrder {
    const char* A; const char* Bt; size_t bstride; const int* idx; volatile LAS int* tb; int nN, nwg, G, c, lim, ubase;
    __device__ __forceinline__ void decode(int w, Unit& u) const {
        int g = 0, base = 0;
#pragma unroll
        for (int j = 1; j < 16; ++j) { const int b = tb[j] * nN; if (w >= b) { g = j; base = b; } }
        const int ntile = tb[g + 1] - tb[g]; pg8::tile_decode(w - base, ntile, nN, u.pm, u.pn); u.g = g;
    }
    __device__ __forceinline__ bool next(int i, Unit& u) const { const long L = (long)i * G + c; if (L >= lim) return false; decode(pg8::xcd_remap((int)L, nwg) + ubase, u); return true; }
};
struct MoeUpOrder : MoeOrder {
    static constexpr bool GATHER = true;
    __device__ __forceinline__ const char* abase(const Unit&, size_t) const { return A; }
    __device__ __forceinline__ const char* bbase(const Unit& u, size_t tstep) const { return Bt + (size_t)(u.g & 7) * bstride + (size_t)u.pn * tstep; }
    __device__ __forceinline__ void avoff(const Unit& u, int wid, int pitchb, unsigned (&vA)[2][2]) const {
        const int cnt = tb[32 + u.g]; const int* ix = idx + (size_t)u.g * M + u.pm * 256; const int tid = wid * 64 + pg8::lane_now();
#pragma unroll
        for (int i = 0; i < 2; ++i) { int R, C; pg8::stage_rc(tid * 16 + i * 8192, R, C);
#pragma unroll
            for (int h = 0; h < 2; ++h) { const int p = u.pm * 256 + 128 * h + R; const int tok = (p < cnt) ? ix[128 * h + R] : 0; vA[h][i] = (unsigned)(tok * pitchb + C * 2); } }
    }
};
struct MoeDownOrder : MoeOrder {
    static constexpr bool GATHER = false;
    __device__ __forceinline__ const char* abase(const Unit& u, size_t tstep) const { return A + (size_t)(tb[u.g] + u.pm) * tstep; }
    __device__ __forceinline__ const char* bbase(const Unit& u, size_t tstep) const { return Bt + (size_t)(u.g & 7) * bstride + (size_t)u.pn * tstep; }
    __device__ __forceinline__ void avoff(const Unit&, int, int, unsigned (&)[2][2]) const {}
};
struct EpiMU {
    static constexpr bool MID = false;
    GAS unsigned char* H; volatile LAS int* tb;
    __device__ __forceinline__ void operator()(const f32x4 (&acc)[2][2][4][2], const Unit& u, int wr, int wc, int fr, int fq) const {
        EPI_LANE; const int colb = u.pn * 128 + 32 * wc + 8 * fq; const int hrow0 = (tb[u.g] + u.pm) * 256;
        GAS unsigned char* hp = H + (size_t)(hrow0 + wr * 64 + fr) * FFE + colb;
        constexpr float K1 = -1.4426950408889634f / SW1, K2 = SH / (SW1 * SW1);
        EPI_FOR_AM { v2u w;
#pragma unroll
            for (int n = 0; n < 2; ++n) { const f32x4 a1 = acc[ai][0][m][n], a3 = acc[ai][1][m][n]; const f32x4 t = a1 * K1; f32x4 d;
#pragma unroll
                for (int e = 0; e < 4; ++e) d[e] = __builtin_amdgcn_exp2f(t[e]);
                d += 1.f; f32x4 r;
#pragma unroll
                for (int e = 0; e < 4; ++e) r[e] = __builtin_amdgcn_rcpf(d[e]);
                const f32x4 h = ((a1 * K2) * a3) * r;
                const unsigned pk = pk4_fp8(h[0], h[1], h[2], h[3]); if (n == 0) w.x = pk; else w.y = pk; }
            *(GAS v2u*)(hp + (size_t)(ai * 128 + m * 16) * FFE) = w; }
    }
};
struct EpiMD {
    static constexpr bool MID = false;
    GAS bf16* x16; GAS float* out; const GAS int* idx; const GAS float* gate; volatile LAS int* tb;
    __device__ __forceinline__ void operator()(const f32x4 (&acc)[2][2][4][2], const Unit& u, int wr, int wc, int fr, int fq) const {
        EPI_LANE; const int colb = u.pn * 256 + 64 * wc + 8 * fq; const int cnt = tb[32 + u.g];
        int tok8[8]; float gt8[8];
#pragma unroll
        for (int it = 0; it < 8; ++it) { const int p = u.pm * 256 + (it >> 2) * 128 + wr * 64 + (it & 3) * 16 + fr; const bool ok = p < cnt; const size_t li = (size_t)u.g * M + (ok ? p : cnt - 1); const int t_ = idx[li]; const float g_ = gate[li]; tok8[it] = ok ? t_ : -1; gt8[it] = ok ? g_ * (1.f / (SH * SW2)) : 0.f; }
        v4u cb[2][4][2];
#pragma unroll
        for (int it = 0; it < 8; ++it) { const int tk = tok8[it]; const GAS bf16* xp = x16 + (size_t)(tk < 0 ? 0 : tk) * DM + colb;
#pragma unroll
            for (int bj = 0; bj < 2; ++bj) cb[it >> 2][it & 3][bj] = *(const GAS v4u*)(xp + 32 * bj); }
#pragma unroll
        for (int ai = 0; ai < 2; ++ai) {
#pragma unroll
            for (int m = 0; m < 4; ++m) { const int tk = tok8[ai * 4 + m];
                if (tk >= 0) { const float gt = gt8[ai * 4 + m]; const size_t off = (size_t)tk * DM + colb;
#pragma unroll
                    for (int bj = 0; bj < 2; ++bj) { const v4u c = cb[ai][m][bj];
                        const f32x4 v0 = (f32x4){bflo(c.x), bfhi(c.x), bflo(c.y), bfhi(c.y)} + acc[ai][bj][m][0] * gt, v1 = (f32x4){bflo(c.z), bfhi(c.z), bflo(c.w), bfhi(c.w)} + acc[ai][bj][m][1] * gt;
                        if (out) { *(GAS f32x4*)(out + off + 32 * bj) = v0; *(GAS f32x4*)(out + off + 32 * bj + 4) = v1; }
                        else { v4u w; w.x = cvt_pk_bf16(v0[0], v0[1]); w.y = cvt_pk_bf16(v0[2], v0[3]); w.z = cvt_pk_bf16(v1[0], v1[1]); w.w = cvt_pk_bf16(v1[2], v1[3]); *(GAS v4u*)(x16 + off + 32 * bj) = w; } } } }
            __builtin_amdgcn_sched_barrier(0); }
    }
};

__device__ __forceinline__ void conv_item(const float* src, int sN, int scol0, int k0, const float* gain, bf16* dst, int dpitch, int drow0, int dk0, LAS float* scr, int lane) {
    const int rg = lane >> 3, c4 = (lane & 7) * 4; f32x4 v[8];
#pragma unroll
    for (int i = 0; i < 8; ++i) v[i] = *(const f32x4*)(src + (size_t)(k0 + 8 * i + rg) * sN + scol0 + c4);
    if (gain) {
#pragma unroll
        for (int i = 0; i < 8; ++i) v[i] *= gain[k0 + 8 * i + rg]; }
#pragma unroll
    for (int i = 0; i < 8; ++i) { LAS float* d = scr + (8 * i + rg) * 33 + c4; d[0] = v[i][0]; d[1] = v[i][1]; d[2] = v[i][2]; d[3] = v[i][3]; }
    LDS_WAIT(); asm volatile("" ::: "memory");
    const int c = lane & 7;
#pragma unroll
    for (int j = 0; j < 4; ++j) { const int o = (lane >> 3) + 8 * j; const int rho = 16 * ((o >> 2) & 1) + 4 * (o >> 3) + (o & 3); const LAS float* s = scr + (8 * c) * 33 + o;
        v4u w; w.x = pk2(s[0 * 33], s[1 * 33]); w.y = pk2(s[2 * 33], s[3 * 33]); w.z = pk2(s[4 * 33], s[5 * 33]); w.w = pk2(s[6 * 33], s[7 * 33]);
        *(v4u*)(dst + (size_t)(drow0 + rho) * dpitch + dk0 + k0 + 8 * c) = w; }
    LDS_WAIT(); asm volatile("" ::: "memory");
}
__device__ __forceinline__ void conv_std(const float* W, int sN, int scol_off, int ncols, const float* gain, bf16* dst, int dpitch, int dk0, int item, LAS float* scr, int lane) {
    const int ng = ncols / 32, kb = item / ng, gi = item % ng; const int tile = gi >> 3, bj = (gi & 7) >> 2, wc = gi & 3;
    conv_item(W, sN, scol_off + 256 * tile + 64 * wc + 32 * bj, 64 * kb, gain, dst, dpitch, 32 * gi, dk0, scr, lane);
}
__device__ __forceinline__ void conv_up(const float* w1, const float* w3, int ff, const float* gain, bf16* dst, int item, LAS float* scr, int lane) {
    const int ng = 2 * ff / 32, kb = item / ng, gi = item % ng; const int pn = gi >> 3, bj = (gi & 7) >> 2, wc = gi & 3;
    conv_item(bj ? w3 : w1, ff, 128 * pn + 32 * wc, 64 * kb, gain, dst, DM, 32 * gi, 0, scr, lane);
}

__device__ __forceinline__ void conv_item8(const float* src, int sN, int scol0, int k0, const float* gain, float scale, unsigned char* dst, int dpitch, int drow0, LAS float* scr, int lane) {
    const int rg = lane >> 3, c4 = (lane & 7) * 4; f32x4 v[8];
#pragma unroll
    for (int i = 0; i < 8; ++i) v[i] = *(const f32x4*)(src + (size_t)(k0 + 8 * i + rg) * sN + scol0 + c4);
#pragma unroll
    for (int i = 0; i < 8; ++i) v[i] *= gain ? gain[k0 + 8 * i + rg] * scale : scale;
#pragma unroll
    for (int i = 0; i < 8; ++i) { LAS float* d = scr + (8 * i + rg) * 33 + c4; d[0] = v[i][0]; d[1] = v[i][1]; d[2] = v[i][2]; d[3] = v[i][3]; }
    LDS_WAIT(); asm volatile("" ::: "memory");
    const int c = lane & 3;
#pragma unroll
    for (int j = 0; j < 2; ++j) { const int o = (lane >> 2) + 16 * j; const int rho = 16 * ((o >> 2) & 1) + 4 * (o >> 3) + (o & 3); const LAS float* s = scr + (16 * c) * 33 + o;
        v4u w; w.x = pk4_fp8(s[0 * 33], s[1 * 33], s[2 * 33], s[3 * 33]); w.y = pk4_fp8(s[4 * 33], s[5 * 33], s[6 * 33], s[7 * 33]); w.z = pk4_fp8(s[8 * 33], s[9 * 33], s[10 * 33], s[11 * 33]); w.w = pk4_fp8(s[12 * 33], s[13 * 33], s[14 * 33], s[15 * 33]);
        *(v4u*)(dst + (size_t)(drow0 + rho) * dpitch + k0 + 16 * c) = w; }
    LDS_WAIT(); asm volatile("" ::: "memory");
}
__device__ __forceinline__ void conv_std8(const float* W, int sN, int ncols, float scale, unsigned char* dst, int dpitch, int item, LAS float* scr, int lane) {
    const int ng = ncols / 32, kb = item / ng, gi = item % ng; const int tile = gi >> 3, bj = (gi & 7) >> 2, wc = gi & 3;
    conv_item8(W, sN, 256 * tile + 64 * wc + 32 * bj, 64 * kb, nullptr, scale, dst, dpitch, 32 * gi, scr, lane);
}
__device__ __forceinline__ void conv_up8(const float* w1, const float* w3, int ff, const float* gain, float scale, unsigned char* dst, int item, LAS float* scr, int lane) {
    const int ng = 2 * ff / 32, kb = item / ng, gi = item % ng; const int pn = gi >> 3, bj = (gi & 7) >> 2, wc = gi & 3;
    conv_item8(bj ? w3 : w1, ff, 128 * pn + 32 * wc, 64 * kb, gain, scale, dst, DM, 32 * gi, scr, lane);
}

__device__ __forceinline__ void p_prologue(const Frame& F_) {
    Frame F = phase_frame(F_);
    LAS float* scr = (LAS float*)(F.lds + RING_OFF + F.wave * 16384);
    const int gw = F.vcu * NWAVES + F.wave, NGW = F.G * NWAVES;
    constexpr int I_A = 16 * (NA / 32), I_C = 16 * (NC / 32), I_G = 16 * (NG / 32), I_PA = 4 * 32, I_PB = 12 * 32, I_PC = 12 * 32, I_O = 16 * 32;
    constexpr int I_L = I_A + I_C + I_G + I_PA + I_PB + I_PC + I_O;
    constexpr int I_13 = 16 * (2 * FFD / 32), I_2 = (FFD / 64) * 32;
    constexpr int NITEMS = 2 * I_L + I_13 + I_2;
    for (int it = gw; it < NITEMS; it += NGW) {
        int r = it;
        if (r < 2 * I_L) { const int l = r / I_L; r -= l * I_L;
            bf16* wl = (bf16*)(F.ws + WS_W + l * SZ_WL); const float* win = F.in[3] + (size_t)l * DM * INCOLS; const float* gn = F.in[1] + l * DM;
            if (r < I_A) { const int ng = NA / 32, kb = r / ng, gi = r % ng; bf16* wa = (bf16*)((char*)wl + OFF_WA);
                if (gi < 72) conv_std(win, INCOLS, 0, 2304, gn, wa, DM, 0, kb * 72 + gi, scr, F.lane);
                else if (gi < 120) { const int pg = gi - 72, pn = pg >> 3, bj = (pg & 7) >> 2, wc = pg & 3;
                    conv_item(win, INCOLS, (bj ? 3840 : 2304) + 128 * pn + 32 * wc, 64 * kb, gn, wa, DM, 32 * gi, 0, scr, F.lane); }
                else { const int tg = gi - 120, tile = tg >> 3, bj = (tg & 7) >> 2, wc = tg & 3;
                    conv_item(win, INCOLS, 3072 + 256 * tile + 64 * wc + 32 * bj, 64 * kb, gn, wa, DM, 32 * gi, 0, scr, F.lane); }
                continue; } r -= I_A;
            if (r < I_C) { conv_std(win, INCOLS, NA, NC, gn, (bf16*)((char*)wl + OFF_WC), DM, 0, r, scr, F.lane); continue; } r -= I_C;
            if (r < I_G) { conv_std(win, INCOLS, NA + NC, NG, gn, (bf16*)((char*)wl + OFF_WG), DM, 0, r, scr, F.lane); continue; } r -= I_G;
            bf16* wp = (bf16*)((char*)wl + OFF_WP);
            if (r < I_PA) { conv_std(F.in[9] + (size_t)l * 256 * DM, DM, 0, DM, nullptr, wp, KP, 0, r, scr, F.lane); continue; } r -= I_PA;
            if (r < I_PB) { conv_std(F.in[10] + (size_t)l * 768 * DM, DM, 0, DM, nullptr, wp, KP, 256, r, scr, F.lane); continue; } r -= I_PB;
            if (r < I_PC) { conv_std(F.in[11] + (size_t)l * 768 * DM, DM, 0, DM, nullptr, wp, KP, 1024, r, scr, F.lane); continue; } r -= I_PC;
            conv_std(F.in[12] + (size_t)l * DM * DM, DM, 0, DM, nullptr, (bf16*)((char*)wl + OFF_WO), DM, 0, r, scr, F.lane); continue;
        }
        r -= 2 * I_L;
        if (r < I_13) { conv_up(F.in[13], F.in[14], FFD, F.in[2], (bf16*)(F.ws + WS_W13), r, scr, F.lane); continue; } r -= I_13;
        conv_std(F.in[15], DM, 0, DM, nullptr, (bf16*)(F.ws + WS_W2), FFD, 0, r, scr, F.lane);
    }
    float* ssq0 = (float*)(F.ws + WS_SSQ); bf16* x16 = (bf16*)(F.ws + WS_X16);
    for (int m = gw; m < M; m += NGW) {
        const f32x4* xr = (const f32x4*)(F.in[0] + (size_t)m * DM) + F.lane; f32x4 v[4]; float s = 0.f;
#pragma unroll
        for (int j = 0; j < 4; ++j) { v[j] = xr[64 * j]; s += (v[j].x * v[j].x + v[j].y * v[j].y) + (v[j].z * v[j].z + v[j].w * v[j].w); }
        s = wave_sum(s);
        v2u* o8 = (v2u*)(x16 + (size_t)m * DM) + F.lane;
#pragma unroll
        for (int j = 0; j < 4; ++j) { v2u w; w.x = pk2(v[j].x, v[j].y); w.y = pk2(v[j].z, v[j].w); o8[64 * j] = w; }
        if (F.lane == 0) *(f32x4*)(ssq0 + (size_t)m * 4) = (f32x4){s, 0.f, 0.f, 0.f};
    }
    float* misc = (float*)(F.ws + WS_MISC);
    const int gt = F.vcu * NTHR + F.tid, NGT = F.G * NTHR;
    for (int i = gt; i < DM * NEXP; i += NGT) misc[MI_RGW + i] = F.in[2][DM + (i >> 3)] * F.in[16][i];
    for (int i = gt; i < 2 * 768; i += NGT) { const int l = i / 768, c = i % 768; float lb = 0.f;
        if (l == 1) { const float p0 = F.in[7][c], p1 = F.in[7][768 + c]; lb = 1.f / (1.f + expf(p0 - p1)); }
        misc[MI_LBA + i] = lb; }
}

typedef short bf16x8_t __attribute__((ext_vector_type(8)));
typedef float f32x16 __attribute__((ext_vector_type(16)));
typedef short v4i16_t __attribute__((ext_vector_type(4)));
constexpr int AT_VSTR = 144, AT_WAVE_LDS = 32 * AT_VSTR + 128;
constexpr int AT_ASTR = 144, AT_ACC = NWAVES * AT_WAVE_LDS, AT_LACC = AT_ACC + 512 * AT_ASTR;
static_assert(AT_LACC + 512 * 4 <= RING_BYTES, "attention lds");
__device__ __forceinline__ void p_attn_mfma(const Frame& F_) {
    Frame F = phase_frame(F_);
    const bf16* QKV = (const bf16*)(F.ws + R_BUFA); bf16* MIX = (bf16*)(F.ws + R_MIX);
    const int lane = F.lane, r32 = lane & 31, hi = lane >> 5;
    LAS unsigned char* wl = F.lds + F.wave * AT_WAVE_LDS;
    LAS unsigned char* vt = wl; LAS float* linv = (LAS float*)(wl + 32 * AT_VSTR);
    LAS unsigned char* accb = F.lds + AT_ACC; LAS float* lacc = (LAS float*)(F.lds + AT_LACC);
    const int li = lane & 15; const int vtr_off = ((li >> 2) + 4 * hi) * AT_VSTR + (16 * ((lane >> 4) & 1) + 4 * (li & 3)) * 2;
    for (int item = F.vcu; item < BATCH * 8 * 4; item += F.G) {
        const int hg = item & 3, bs = (item >> 2) & 7, b = item >> 5;
#pragma unroll 1
        for (int g = 0; g < 3; ++g) {
            const int d = 1 << (2 * g), head = 4 * g + hg;
#pragma unroll 1
            for (int rep = 0; rep < 2; ++rep) {
                const int k = F.wave + 8 * rep, rho = k & (d - 1), chunk = k >> (2 * g);
                const int qpos0 = ((512 * bs) >> (2 * g)) + 32 * chunk;
                const int base = qpos0 - 128;
                const int lt0 = rho + d * 32 * chunk;
                const size_t tok0 = (size_t)b * SEQ + rho;
                f32x16 o0, o1; float l = 0.f;
                if (g == 0) {
#pragma unroll
                    for (int i = 0; i < 16; ++i) { o0[i] = 0.f; o1[i] = 0.f; }
                } else {
#pragma unroll
                    for (int i = 0; i < 16; ++i) { const int q = (i & 3) + 8 * (i >> 2) + 4 * hi; const LAS unsigned short* ap = (const LAS unsigned short*)(accb + (lt0 + d * q) * AT_ASTR) + r32;
                        o0[i] = __uint_as_float((unsigned)ap[0] << 16); o1[i] = __uint_as_float((unsigned)ap[32] << 16); }
                }
                bf16x8_t qf[4];
                { const bf16* qp = QKV + (tok0 + (size_t)d * (qpos0 + r32)) * NAO + head * 64 + 8 * hi;
#pragma unroll
                  for (int d0 = 0; d0 < 4; ++d0) qf[d0] = *(const bf16x8_t*)(qp + 16 * d0); }
                const bf16* kbase = QKV + tok0 * NAO + 768 + head * 64 + 8 * hi;
                const bf16* vbase = QKV + tok0 * NAO + 1536 + head * 64 + (lane & 7) * 8;
                constexpr int ntile = (128 + 31) / 32 + 1;
                int t0 = 0; if (base < -31) t0 = (-base) >> 5;
                bf16x8_t kf[4]; v4u vf[4];
                { const int kidx = base + 32 * t0 + r32; const bf16* kp = kbase + (size_t)d * (kidx < 0 ? 0 : kidx) * NAO;
#pragma unroll
                  for (int d0 = 0; d0 < 4; ++d0) kf[d0] = *(const bf16x8_t*)(kp + 16 * d0);
#pragma unroll
                  for (int i = 0; i < 4; ++i) { const int vi = base + 32 * t0 + (lane >> 3) + 8 * i; vf[i] = *(const v4u*)(vbase + (size_t)d * (vi < 0 ? 0 : vi) * NAO); } }
                const int c0 = 128 + r32 - 4 * hi;
#pragma unroll 1
                for (int t = t0; t < ntile; ++t) {
#pragma unroll
                    for (int i = 0; i < 4; ++i) *(LAS v4u*)(vt + ((lane >> 3) + 8 * i) * AT_VSTR + (lane & 7) * 16) = vf[i];
                    bf16x8_t kc[4];
#pragma unroll
                    for (int d0 = 0; d0 < 4; ++d0) kc[d0] = kf[d0];
                    if (t + 1 < ntile) { const int kidx = base + 32 * (t + 1) + r32; const bf16* kp = kbase + (size_t)d * (kidx < 0 ? 0 : kidx) * NAO;
#pragma unroll
                        for (int d0 = 0; d0 < 4; ++d0) kf[d0] = *(const bf16x8_t*)(kp + 16 * d0);
#pragma unroll
                        for (int i = 0; i < 4; ++i) { const int vi = base + 32 * (t + 1) + (lane >> 3) + 8 * i; vf[i] = *(const v4u*)(vbase + (size_t)d * (vi < 0 ? 0 : vi) * NAO); } }
                    f32x16 p;
#pragma unroll
                    for (int i = 0; i < 16; ++i) p[i] = 0.f;
#pragma unroll
                    for (int d0 = 0; d0 < 4; ++d0) p = __builtin_amdgcn_mfma_f32_32x32x16_bf16(kc[d0], qf[d0], p, 0, 0, 0);
                    const int cr = c0 - 32 * t, ck = base + 32 * t + 4 * hi;
#pragma unroll
                    for (int i = 0; i < 16; ++i) { const int kk = (i & 3) + 8 * (i >> 2); const bool ok = ((unsigned)(cr - kk) <= 128u) && (ck + kk >= 0);
                        const float e = __builtin_amdgcn_exp2f(p[i]); p[i] = ok ? e : 0.f; l += p[i]; }
                    bf16x8_t pa0, pa1;
                    { v4u w0, w1; w0.x = cvt_pk_bf16(p[0], p[1]); w0.y = cvt_pk_bf16(p[2], p[3]); w0.z = cvt_pk_bf16(p[4], p[5]); w0.w = cvt_pk_bf16(p[6], p[7]);
                      w1.x = cvt_pk_bf16(p[8], p[9]); w1.y = cvt_pk_bf16(p[10], p[11]); w1.z = cvt_pk_bf16(p[12], p[13]); w1.w = cvt_pk_bf16(p[14], p[15]);
                      pa0 = __builtin_bit_cast(bf16x8_t, w0); pa1 = __builtin_bit_cast(bf16x8_t, w1); }
#pragma unroll
                    for (int db = 0; db < 2; ++db) {
                        bf16x8_t vb[2];
#pragma unroll
                        for (int ss = 0; ss < 2; ++ss) {
                            const v4i16_t lo = __builtin_amdgcn_ds_read_tr16_b64_v4i16((LAS v4i16_t*)(vt + vtr_off + (16 * ss) * AT_VSTR + db * 64));
                            const v4i16_t hh = __builtin_amdgcn_ds_read_tr16_b64_v4i16((LAS v4i16_t*)(vt + vtr_off + (16 * ss + 8) * AT_VSTR + db * 64));
                            vb[ss] = (bf16x8_t){lo[0], lo[1], lo[2], lo[3], hh[0], hh[1], hh[2], hh[3]}; }
                        if (db == 0) { o0 = __builtin_amdgcn_mfma_f32_32x32x16_bf16(pa0, vb[0], o0, 0, 0, 0); o0 = __builtin_amdgcn_mfma_f32_32x32x16_bf16(pa1, vb[1], o0, 0, 0, 0); }
                        else         { o1 = __builtin_amdgcn_mfma_f32_32x32x16_bf16(pa0, vb[0], o1, 0, 0, 0); o1 = __builtin_amdgcn_mfma_f32_32x32x16_bf16(pa1, vb[1], o1, 0, 0, 0); }
                    }
                }
                l += __shfl_xor(l, 32);
                if (g < 2) {
                    if (hi == 0) lacc[lt0 + d * r32] = (g == 0) ? l : l + lacc[lt0 + d * r32];
#pragma unroll
                    for (int i = 0; i < 16; ++i) { const int q = (i & 3) + 8 * (i >> 2) + 4 * hi; LAS unsigned short* ap = (LAS unsigned short*)(accb + (lt0 + d * q) * AT_ASTR) + r32;
                        ap[0] = (unsigned short)f2bf(o0[i]); ap[32] = (unsigned short)f2bf(o1[i]); }
                } else {
                    if (hi == 0) linv[r32] = 1.f / (l + lacc[lt0 + d * r32]);
#pragma unroll
                    for (int i = 0; i < 16; ++i) { const int q = (i & 3) + 8 * (i >> 2) + 4 * hi; const float il = linv[q]; LAS unsigned short* ap = (LAS unsigned short*)(accb + (lt0 + d * q) * AT_ASTR) + r32;
                        ap[0] = (unsigned short)f2bf(o0[i] * il); ap[32] = (unsigned short)f2bf(o1[i] * il); }
#pragma unroll
                    for (int i = 0; i < 4; ++i) { const int q = (lane >> 3) + 8 * i; const v4u w = *(const LAS v4u*)(accb + (lt0 + d * q) * AT_ASTR + (lane & 7) * 16);
                        *(v4u*)(MIX + ((size_t)b * SEQ + 512 * bs + lt0 + d * q) * KP + hg * 64 + (lane & 7) * 8) = w; }
                }
            }
            __syncthreads();
        }
    }
}
__device__ __forceinline__ void p_conv(const Frame& F_, int l) {
    Frame F = phase_frame(F_);
    const bf16* P = (const bf16*)(F.ws + R_BUFA); bf16* MIX = (bf16*)(F.ws + R_MIX); const float* cw = F.in[6] + l * 3 * 768;
    if (F.tid < 384) {
        const int tl = F.tid / 96, c8 = (F.tid % 96) * 8;
        f32x4 w[3][2];
#pragma unroll
        for (int j = 0; j < 3; ++j) { w[j][0] = *(const f32x4*)(cw + 768 * j + c8); w[j][1] = *(const f32x4*)(cw + 768 * j + c8 + 4); }
        for (int blk = F.vcu; blk < M / 128; blk += F.G) {
            const int t0 = blk * 128 + tl * 32, s0 = t0 & (SEQ - 1);
            v4u hw1 = {0u, 0u, 0u, 0u}, hw2 = {0u, 0u, 0u, 0u};
            if (s0 >= 1) hw1 = *(const v4u*)(P + (size_t)(t0 - 1) * NAO + 2304 + c8);
            if (s0 >= 2) hw2 = *(const v4u*)(P + (size_t)(t0 - 2) * NAO + 2304 + c8);
            f32x4 h1[2] = {(f32x4){bflo(hw1.x), bfhi(hw1.x), bflo(hw1.y), bfhi(hw1.y)}, (f32x4){bflo(hw1.z), bfhi(hw1.z), bflo(hw1.w), bfhi(hw1.w)}};
            f32x4 h2[2] = {(f32x4){bflo(hw2.x), bfhi(hw2.x), bflo(hw2.y), bfhi(hw2.y)}, (f32x4){bflo(hw2.z), bfhi(hw2.z), bflo(hw2.w), bfhi(hw2.w)}};
#pragma unroll 1
            for (int i0 = 0; i0 < 32; i0 += 8) {
                v4u uu[8], bb[8];
#pragma unroll
                for (int i = 0; i < 8; ++i) { const bf16* rp = P + (size_t)(t0 + i0 + i) * NAO + c8; uu[i] = *(const v4u*)(rp + 2304); bb[i] = *(const v4u*)(rp + 3072); }
#pragma unroll
                for (int i = 0; i < 8; ++i) {
                    const f32x4 u0[2] = {(f32x4){bflo(uu[i].x), bfhi(uu[i].x), bflo(uu[i].y), bfhi(uu[i].y)}, (f32x4){bflo(uu[i].z), bfhi(uu[i].z), bflo(uu[i].w), bfhi(uu[i].w)}};
                    const f32x4 g[2] = {(f32x4){bflo(bb[i].x), bfhi(bb[i].x), bflo(bb[i].y), bfhi(bb[i].y)}, (f32x4){bflo(bb[i].z), bfhi(bb[i].z), bflo(bb[i].w), bfhi(bb[i].w)}};
                    f32x4 y[2];
#pragma unroll
                    for (int n = 0; n < 2; ++n) { y[n] = g[n] * (w[0][n] * u0[n] + w[1][n] * h1[n] + w[2][n] * h2[n]); h2[n] = h1[n]; h1[n] = u0[n]; }
                    v4u o; o.x = cvt_pk_bf16(y[0][0], y[0][1]); o.y = cvt_pk_bf16(y[0][2], y[0][3]); o.z = cvt_pk_bf16(y[1][0], y[1][1]); o.w = cvt_pk_bf16(y[1][2], y[1][3]);
                    *(v4u*)(MIX + (size_t)(t0 + i0 + i) * KP + 256 + c8) = o; }
            }
        }
    }
}
typedef float f32x4v __attribute__((ext_vector_type(4)));
constexpr int HS = 272;
constexpr int H1_LF = 0, H1_BF = 16384, H1_QT = 49152, H1_KT = H1_QT + 64 * HS, H1_VT = H1_KT + 64 * HS, H1_PS = H1_VT + 64 * HS, H1_BSEG = H1_PS + 2048, H1_EREF = H1_BSEG + 512, H1_LAM = H1_EREF + 512;
static_assert(H1_LAM + 512 <= RING_BYTES, "hgrn lds");
__device__ __forceinline__ bf16x8_t trpair(LAS unsigned char* p0, LAS unsigned char* p1) {
    const v4i16_t a = __builtin_amdgcn_ds_read_tr16_b64_v4i16((LAS v4i16_t*)p0), b = __builtin_amdgcn_ds_read_tr16_b64_v4i16((LAS v4i16_t*)p1);
    return (bf16x8_t){a[0], a[1], a[2], a[3], b[0], b[1], b[2], b[3]};
}
__device__ __forceinline__ bf16x8_t pack8(const f32x4v a, const f32x4v b) { v4u w; w.x = cvt_pk_bf16(a[0], a[1]); w.y = cvt_pk_bf16(a[2], a[3]); w.z = cvt_pk_bf16(b[0], b[1]); w.w = cvt_pk_bf16(b[2], b[3]); return __builtin_bit_cast(bf16x8_t, w); }
__device__ __forceinline__ void unpack8(const v4u w, float (&x)[8]) { x[0] = bflo(w.x); x[1] = bfhi(w.x); x[2] = bflo(w.y); x[3] = bfhi(w.y); x[4] = bflo(w.z); x[5] = bfhi(w.z); x[6] = bflo(w.w); x[7] = bfhi(w.w); }
__device__ __forceinline__ void p_hgrn1_mfma(const Frame& F_) {
    Frame F = phase_frame(F_);
    const bf16* HGB = (const bf16*)(F.ws + R_HG); bf16* OL = (bf16*)(F.ws + R_OLOC); bf16* QD = (bf16*)(F.ws + R_QD); float* FST = (float*)(F.ws + R_FST); float* DST = (float*)(F.ws + R_DST);
    LAS unsigned char* L = F.lds;
    const int tid = F.tid, lane = F.lane, w = F.wave, c16 = lane & 15, g = lane >> 4;
    const int st = tid >> 3, sk = (tid & 7) * 16;
    const int ck = tid & 127, cq = tid >> 7;
    for (int item = F.vcu; item < BATCH * HG_H * HSEG; item += F.G) {
        const int bh = item / HSEG, j = item % HSEG, b = bh / HG_H, h = bh % HG_H; const int tok0 = b * SEQ + j * HSEGLEN;
        f32x4v S[8];
#pragma unroll
        for (int i = 0; i < 8; ++i) S[i] = (f32x4v){0.f, 0.f, 0.f, 0.f};
        if (tid < 128) *(LAS float*)(L + H1_BSEG + 4 * tid) = 0.f;
        v4u rq[2], rf[2], rv[2];
        { const bf16* rp = HGB + (size_t)(tok0 + st) * NC + h * 128 + sk;
          rq[0] = *(const v4u*)rp; rq[1] = *(const v4u*)(rp + 8); rf[0] = *(const v4u*)(rp + 768); rf[1] = *(const v4u*)(rp + 776); rv[0] = *(const v4u*)(rp + 1536); rv[1] = *(const v4u*)(rp + 1544); }
#pragma unroll 1
        for (int ch = 0; ch < HSEGLEN / 64; ++ch) {
            const int ctok = tok0 + ch * 64;
            *(LAS v4u*)(L + H1_LF + st * 256 + sk * 2) = rf[0]; *(LAS v4u*)(L + H1_LF + st * 256 + sk * 2 + 16) = rf[1];
            *(LAS v4u*)(L + H1_VT + st * HS + sk * 2) = rv[0]; *(LAS v4u*)(L + H1_VT + st * HS + sk * 2 + 16) = rv[1];
            __syncthreads();
            float cs[16];
            { float a = 0.f;
#pragma unroll
              for (int i = 0; i < 16; ++i) { a += bflo((unsigned)*(const LAS unsigned short*)(L + H1_LF + (16 * cq + i) * 256 + ck * 2)); cs[i] = a; }
              *(LAS float*)(L + H1_PS + (cq * 128 + ck) * 4) = a; }
            __syncthreads();
            { float pre = 0.f;
#pragma unroll
              for (int qq = 0; qq < 3; ++qq) { const float pv = *(const LAS float*)(L + H1_PS + (qq * 128 + ck) * 4); pre += (qq < cq) ? pv : 0.f; }
#pragma unroll
              for (int i = 0; i < 16; ++i) *(LAS float*)(L + H1_BF + (16 * cq + i) * 512 + ck * 4) = pre + cs[i]; }
            __syncthreads();
            { float q[16], lf[16]; unpack8(rq[0], (float(&)[8])q[0]); unpack8(rq[1], (float(&)[8])q[8]); unpack8(rf[0], (float(&)[8])lf[0]); unpack8(rf[1], (float(&)[8])lf[8]);
              float qt[16], kt[16], qd[16];
#pragma unroll
              for (int c4 = 0; c4 < 4; ++c4) { const f32x4v Bt = *(const LAS f32x4v*)(L + H1_BF + st * 512 + (sk + 4 * c4) * 4), Br = *(const LAS f32x4v*)(L + H1_BF + 31 * 512 + (sk + 4 * c4) * 4), Bs = *(const LAS f32x4v*)(L + H1_BSEG + (sk + 4 * c4) * 4);
#pragma unroll
                  for (int e = 0; e < 4; ++e) { const int i = 4 * c4 + e; const float d1 = Bt[e] - Br[e];
                      qt[i] = q[i] * fast_exp(d1); kt[i] = (1.f - fast_exp(lf[i])) * fast_exp(-d1); qd[i] = q[i] * fast_exp(Bs[e] + Bt[e]); } }
              v4u wq0, wq1, wk0, wk1, wd0, wd1;
              wq0.x = cvt_pk_bf16(qt[0], qt[1]); wq0.y = cvt_pk_bf16(qt[2], qt[3]); wq0.z = cvt_pk_bf16(qt[4], qt[5]); wq0.w = cvt_pk_bf16(qt[6], qt[7]); wq1.x = cvt_pk_bf16(qt[8], qt[9]); wq1.y = cvt_pk_bf16(qt[10], qt[11]); wq1.z = cvt_pk_bf16(qt[12], qt[13]); wq1.w = cvt_pk_bf16(qt[14], qt[15]);
              wk0.x = cvt_pk_bf16(kt[0], kt[1]); wk0.y = cvt_pk_bf16(kt[2], kt[3]); wk0.z = cvt_pk_bf16(kt[4], kt[5]); wk0.w = cvt_pk_bf16(kt[6], kt[7]); wk1.x = cvt_pk_bf16(kt[8], kt[9]); wk1.y = cvt_pk_bf16(kt[10], kt[11]); wk1.z = cvt_pk_bf16(kt[12], kt[13]); wk1.w = cvt_pk_bf16(kt[14], kt[15]);
              wd0.x = cvt_pk_bf16(qd[0], qd[1]); wd0.y = cvt_pk_bf16(qd[2], qd[3]); wd0.z = cvt_pk_bf16(qd[4], qd[5]); wd0.w = cvt_pk_bf16(qd[6], qd[7]); wd1.x = cvt_pk_bf16(qd[8], qd[9]); wd1.y = cvt_pk_bf16(qd[10], qd[11]); wd1.z = cvt_pk_bf16(qd[12], qd[13]); wd1.w = cvt_pk_bf16(qd[14], qd[15]);
              *(LAS v4u*)(L + H1_QT + st * HS + sk * 2) = wq0; *(LAS v4u*)(L + H1_QT + st * HS + sk * 2 + 16) = wq1;
              *(LAS v4u*)(L + H1_KT + st * HS + sk * 2) = wk0; *(LAS v4u*)(L + H1_KT + st * HS + sk * 2 + 16) = wk1;
              bf16* dp = QD + (size_t)(ctok + st) * 768 + h * 128 + sk; *(v4u*)dp = wd0; *(v4u*)(dp + 8) = wd1; }
            if (tid < 128) { const float b31 = *(const LAS float*)(L + H1_BF + 31 * 512 + tid * 4), b63 = *(const LAS float*)(L + H1_BF + 63 * 512 + tid * 4);
                *(LAS float*)(L + H1_EREF + tid * 4) = fast_exp(b31); *(LAS float*)(L + H1_LAM + tid * 4) = fast_exp(b63 - b31); }
            if (ch + 1 < HSEGLEN / 64) { const bf16* rp = HGB + (size_t)(ctok + 64 + st) * NC + h * 128 + sk;
                rq[0] = *(const v4u*)rp; rq[1] = *(const v4u*)(rp + 8); rf[0] = *(const v4u*)(rp + 768); rf[1] = *(const v4u*)(rp + 776); rv[0] = *(const v4u*)(rp + 1536); rv[1] = *(const v4u*)(rp + 1544); }
            __syncthreads();
            if (tid < 128) *(LAS float*)(L + H1_BSEG + 4 * tid) += *(const LAS float*)(L + H1_BF + 63 * 512 + tid * 4);
            bf16x8_t sa[4];
#pragma unroll
            for (int kt8 = 0; kt8 < 8; ++kt8) S[kt8] *= *(const LAS f32x4v*)(L + H1_EREF + (16 * kt8 + 4 * g) * 4);
#pragma unroll
            for (int kb = 0; kb < 4; ++kb) sa[kb] = pack8(S[2 * kb], S[2 * kb + 1]);
            bf16x8_t vtf[2];
            { LAS unsigned char* vb = L + H1_VT + (4 * g + (c16 >> 2)) * HS + (16 * w + 4 * (c16 & 3)) * 2;
#pragma unroll
              for (int p = 0; p < 2; ++p) vtf[p] = trpair(vb + (32 * p) * HS, vb + (32 * p + 16) * HS); }
#pragma unroll
            for (int tt = 0; tt < 4; ++tt) {
                bf16x8_t qn[4];
#pragma unroll
                for (int ks = 0; ks < 4; ++ks) qn[ks] = *(const LAS bf16x8_t*)(L + H1_QT + (16 * tt + c16) * HS + (32 * ks + 8 * g) * 2);
                f32x4v at[4];
#pragma unroll
                for (int a = 0; a < 4; ++a) { at[a] = (f32x4v){0.f, 0.f, 0.f, 0.f};
                    if (a <= tt) {
#pragma unroll
                        for (int ks = 0; ks < 4; ++ks) { const bf16x8_t kf = *(const LAS bf16x8_t*)(L + H1_KT + (16 * a + c16) * HS + (32 * ks + 8 * g) * 2);
                            at[a] = __builtin_amdgcn_mfma_f32_16x16x32_bf16(kf, qn[ks], at[a], 0, 0, 0); }
                        if (a == tt) {
#pragma unroll
                            for (int e = 0; e < 4; ++e) at[a][e] = (4 * g + e <= c16) ? at[a][e] : 0.f; } } }
                f32x4v o = (f32x4v){0.f, 0.f, 0.f, 0.f};
                o = __builtin_amdgcn_mfma_f32_16x16x32_bf16(vtf[0], pack8(at[0], at[1]), o, 0, 0, 0);
                if (tt >= 2) o = __builtin_amdgcn_mfma_f32_16x16x32_bf16(vtf[1], pack8(at[2], at[3]), o, 0, 0, 0);
#pragma unroll
                for (int kb = 0; kb < 4; ++kb) {
                    const LAS unsigned char* qp = L + H1_QT + (16 * tt + c16) * HS + (32 * kb + 4 * g) * 2;
                    const v2u lo = *(const LAS v2u*)qp, hh = *(const LAS v2u*)(qp + 32); v4u qq; qq.x = lo.x; qq.y = lo.y; qq.z = hh.x; qq.w = hh.y;
                    o = __builtin_amdgcn_mfma_f32_16x16x32_bf16(sa[kb], __builtin_bit_cast(bf16x8_t, qq), o, 0, 0, 0); }
                { v2u ow; ow.x = cvt_pk_bf16(o[0], o[1]); ow.y = cvt_pk_bf16(o[2], o[3]); *(v2u*)(OL + (size_t)(ctok + 16 * tt + c16) * 768 + h * 128 + 16 * w + 4 * g) = ow; }
            }
            { bf16x8_t vf[2];
              LAS unsigned char* vb = L + H1_VT + (8 * g + (c16 >> 2)) * HS + (16 * w + 4 * (c16 & 3)) * 2;
#pragma unroll
              for (int p = 0; p < 2; ++p) vf[p] = trpair(vb + (32 * p) * HS, vb + (32 * p + 4) * HS);
#pragma unroll
              for (int kt8 = 0; kt8 < 8; ++kt8) {
                  LAS unsigned char* kb_ = L + H1_KT + (8 * g + (c16 >> 2)) * HS + (16 * kt8 + 4 * (c16 & 3)) * 2;
#pragma unroll
                  for (int p = 0; p < 2; ++p) S[kt8] = __builtin_amdgcn_mfma_f32_16x16x32_bf16(trpair(kb_ + (32 * p) * HS, kb_ + (32 * p + 4) * HS), vf[p], S[kt8], 0, 0, 0);
                  S[kt8] *= *(const LAS f32x4v*)(L + H1_LAM + (16 * kt8 + 4 * g) * 4); } }
            __syncthreads();
        }
        { bf16* fp = (bf16*)FST + (size_t)item * 16384 + (size_t)(16 * w + c16) * 128 + 4 * g;
#pragma unroll
          for (int kt8 = 0; kt8 < 8; ++kt8) { v2u ow; ow.x = cvt_pk_bf16(S[kt8][0], S[kt8][1]); ow.y = cvt_pk_bf16(S[kt8][2], S[kt8][3]); *(v2u*)(fp + 16 * kt8) = ow; } }
        if (tid < 128) DST[item * 128 + tid] = fast_exp(*(const LAS float*)(L + H1_BSEG + 4 * tid));
        __syncthreads();
    }
}
constexpr int H2_TT = 0, H2_OG = 128 * HS, H2_DT = H2_OG + 512;
__device__ __forceinline__ void p_hgrn2_mfma(const Frame& F_, int l) {
    Frame F = phase_frame(F_);
    const bf16* HGB = (const bf16*)(F.ws + R_HG); const bf16* OL = (const bf16*)(F.ws + R_OLOC); const bf16* QD = (const bf16*)(F.ws + R_QD); const float* FST = (const float*)(F.ws + R_FST); const float* DST = (const float*)(F.ws + R_DST);
    bf16* MIX = (bf16*)(F.ws + R_MIX); const float* og = F.in[8] + l * 128;
    LAS unsigned char* L = F.lds;
    const int tid = F.tid, lane = F.lane, w = F.wave, c16 = lane & 15, g = lane >> 4;
    const int cv = tid >> 2, ckq = (tid & 3) * 32;
    for (int wi = F.vcu; wi < BATCH * HG_H * 5; wi += F.G) {
        const int bh = wi / 5, part = wi % 5, b = bh / HG_H, h = bh % HG_H; const int j0 = (part == 0) ? 0 : 3 * part + 1, j1 = 3 * part + 4;
        f32x4v T[8];
#pragma unroll
        for (int i = 0; i < 8; ++i) T[i] = (f32x4v){0.f, 0.f, 0.f, 0.f};
        __syncthreads();
#pragma unroll
        for (int i = 0; i < 4; ++i) *(LAS float*)(L + H2_DT + 4 * (tid + 512 * i)) = DST[bh * HSEG * 128 + tid + 512 * i];
        __syncthreads();
        for (int i0 = 0; i0 < j0; i0 += 4) {
            v4u fw[4][4];
#pragma unroll
            for (int u = 0; u < 4; ++u) { const int i = (i0 + u < j0) ? i0 + u : j0 - 1; const bf16* fp = (const bf16*)FST + (size_t)(bh * HSEG + i) * 16384 + cv * 128 + ckq;
#pragma unroll
                for (int e = 0; e < 4; ++e) fw[u][e] = *(const v4u*)(fp + 8 * e); }
#pragma unroll
            for (int u = 0; u < 4; ++u) { if (i0 + u < j0) { const LAS float* dp = (const LAS float*)(L + H2_DT) + (i0 + u) * 128 + ckq;
#pragma unroll
                for (int e = 0; e < 4; ++e) { const v4u f = fw[u][e];
                    T[2 * e] = *(const LAS f32x4v*)(dp + 8 * e) * T[2 * e] + (f32x4v){bflo(f.x), bfhi(f.x), bflo(f.y), bfhi(f.y)}; T[2 * e + 1] = *(const LAS f32x4v*)(dp + 8 * e + 4) * T[2 * e + 1] + (f32x4v){bflo(f.z), bfhi(f.z), bflo(f.w), bfhi(f.w)}; } } }
        }
        if (tid < 128) *(LAS float*)(L + H2_OG + 4 * tid) = og[tid];
#pragma unroll 1
        for (int j = j0; j < j1; ++j) {
            const int tok0 = b * SEQ + j * HSEGLEN;
            v2u ol[2][8], gg[2][8]; bf16x8_t qf[2][4];
#pragma unroll
            for (int t2 = 0; t2 < 2; ++t2) { const int tok = tok0 + 16 * (2 * w + t2) + c16;
#pragma unroll
                for (int vt = 0; vt < 8; ++vt) ol[t2][vt] = *(const v2u*)(OL + (size_t)tok * 768 + h * 128 + 16 * vt + 4 * g);
                if (j > 0) {
#pragma unroll
                    for (int ks = 0; ks < 4; ++ks) qf[t2][ks] = *(const bf16x8_t*)(QD + (size_t)tok * 768 + h * 128 + 32 * ks + 8 * g); }
#pragma unroll
                for (int vt = 0; vt < 8; ++vt) gg[t2][vt] = *(const v2u*)(HGB + (size_t)tok * NC + 2304 + h * 128 + 16 * vt + 4 * g); }
            if (j > 0) {
#pragma unroll
                for (int e = 0; e < 4; ++e) *(LAS bf16x8_t*)(L + H2_TT + cv * HS + (ckq + 8 * e) * 2) = pack8(T[2 * e], T[2 * e + 1]); }
            __syncthreads();
            if (j + 1 < j1) { const bf16* fp = (const bf16*)FST + (size_t)(bh * HSEG + j) * 16384 + cv * 128 + ckq; const LAS float* dp = (const LAS float*)(L + H2_DT) + j * 128 + ckq;
#pragma unroll
                for (int e = 0; e < 4; ++e) { const v4u fw = *(const v4u*)(fp + 8 * e);
                    T[2 * e] = *(const LAS f32x4v*)(dp + 8 * e) * T[2 * e] + (f32x4v){bflo(fw.x), bfhi(fw.x), bflo(fw.y), bfhi(fw.y)}; T[2 * e + 1] = *(const LAS f32x4v*)(dp + 8 * e + 4) * T[2 * e + 1] + (f32x4v){bflo(fw.z), bfhi(fw.z), bflo(fw.w), bfhi(fw.w)}; } }
#pragma unroll
            for (int t2 = 0; t2 < 2; ++t2) {
                const int tok = tok0 + 16 * (2 * w + t2) + c16;
                f32x4v o[8];
#pragma unroll
                for (int vt = 0; vt < 8; ++vt) { const v2u x = ol[t2][vt]; o[vt] = (f32x4v){bflo(x.x), bfhi(x.x), bflo(x.y), bfhi(x.y)}; }
                if (j > 0) {
#pragma unroll
                    for (int vt = 0; vt < 8; ++vt)
#pragma unroll
                        for (int ks = 0; ks < 4; ++ks) { const bf16x8_t tf = *(const LAS bf16x8_t*)(L + H2_TT + (16 * vt + c16) * HS + (32 * ks + 8 * g) * 2);
                            o[vt] = __builtin_amdgcn_mfma_f32_16x16x32_bf16(tf, qf[t2][ks], o[vt], 0, 0, 0); }
                }
                float ss = 0.f;
#pragma unroll
                for (int vt = 0; vt < 8; ++vt) ss += (o[vt][0] * o[vt][0] + o[vt][1] * o[vt][1]) + (o[vt][2] * o[vt][2] + o[vt][3] * o[vt][3]);
                ss += __shfl_xor(ss, 16); ss += __shfl_xor(ss, 32);
                const float r = __builtin_amdgcn_rsqf(ss * (1.f / 128.f) + RMS_EPS);
#pragma unroll
                for (int vt = 0; vt < 8; ++vt) { const int vv = 16 * vt + 4 * g; const f32x4v gn = *(const LAS f32x4v*)(L + H2_OG + 4 * vv); const v2u gx = gg[t2][vt];
                    v2u ow; ow.x = cvt_pk_bf16(o[vt][0] * r * gn[0] * bflo(gx.x), o[vt][1] * r * gn[1] * bfhi(gx.x)); ow.y = cvt_pk_bf16(o[vt][2] * r * gn[2] * bflo(gx.y), o[vt][3] * r * gn[3] * bfhi(gx.y));
                    *(v2u*)(MIX + (size_t)tok * KP + 1024 + h * 128 + vv) = ow; }
            }
            __syncthreads();
        }
    }
}
__device__ __forceinline__ void p_route(const Frame& F_) {
    Frame F = phase_frame(F_);
    LAS float* gwt = (LAS float*)(F.lds + 65536);
    const float* misc = (const float*)(F.ws + WS_MISC);
    for (int i = F.tid; i < DM * NEXP; i += NTHR) { const int k = i >> 3, e = i & 7, slot = (8 * (k >> 9) + (k & 7)) * 64 + ((k >> 3) & 63); gwt[(e >> 2) * 4096 + slot * 4 + (e & 3)] = misc[MI_RGW + i]; }
    LAS unsigned* lcnt = (LAS unsigned*)(F.lds + 98304); LAS unsigned* lbase = lcnt + 16; LAS int* rrow = (LAS int*)(F.lds + 98304 + 256);
    if (F.tid < 16) lcnt[F.tid] = 0u;
    __syncthreads();
    const int gw = F.vcu * NWAVES + F.wave, NGW = F.G * NWAVES;
    int* lidx = (int*)(F.ws + R_LIST); float* lgate = (float*)(F.ws + R_LIST) + 16 * M;
    unsigned* cnt = F.ctl + CW_CNT;
    int nrow = 0;
    for (int m = gw; m < M; m += NGW) {
        const v4u* xr = (const v4u*)((const bf16*)(F.ws + WS_X16) + (size_t)m * DM) + F.lane; float lg[8]; float s = 0.f; v4u xk[2];
#pragma unroll
        for (int e = 0; e < 8; ++e) lg[e] = 0.f;
#pragma unroll
        for (int jj = 0; jj < 2; ++jj) { const v4u xw = xr[64 * jj]; xk[jj] = xw; const float x[8] = {bflo(xw.x), bfhi(xw.x), bflo(xw.y), bfhi(xw.y), bflo(xw.z), bfhi(xw.z), bflo(xw.w), bfhi(xw.w)};
#pragma unroll
            for (int c = 0; c < 8; ++c) { s += x[c] * x[c]; const int slot = (8 * jj + c) * 64 + F.lane; const f32x4 w0 = *(const LAS f32x4*)(gwt + slot * 4), w1 = *(const LAS f32x4*)(gwt + 4096 + slot * 4);
                lg[0] += x[c] * w0[0]; lg[1] += x[c] * w0[1]; lg[2] += x[c] * w0[2]; lg[3] += x[c] * w0[3]; lg[4] += x[c] * w1[0]; lg[5] += x[c] * w1[1]; lg[6] += x[c] * w1[2]; lg[7] += x[c] * w1[3]; } }
        s = wave_sum(s);
        const float rs = __builtin_amdgcn_rsqf(s * (1.f / DM) + RMS_EPS);
        { unsigned char* x8r = F.ws + R_X8 + (size_t)m * DM + 8 * F.lane;
#pragma unroll
          for (int jj = 0; jj < 2; ++jj) { const v4u xw = xk[jj]; v2u w; w.x = pk4_fp8(bflo(xw.x) * rs, bfhi(xw.x) * rs, bflo(xw.y) * rs, bfhi(xw.y) * rs); w.y = pk4_fp8(bflo(xw.z) * rs, bfhi(xw.z) * rs, bflo(xw.w) * rs, bfhi(xw.w) * rs); *(v2u*)(x8r + 512 * jj) = w; } }
#pragma unroll
        for (int e = 0; e < 8; ++e) lg[e] = wave_sum(lg[e]);
        if (F.lane == 0) {
            int e1 = 0; float v1 = lg[0];
#pragma unroll
            for (int e = 1; e < 8; ++e) if (lg[e] > v1) { v1 = lg[e]; e1 = e; }
            int e2 = (e1 + 1) & 7; float v2 = -3.0e38f;
#pragma unroll
            for (int e = 0; e < 8; ++e) if (e != e1 && lg[e] > v2) { v2 = lg[e]; e2 = e; }
            const float g1 = 1.f / (1.f + expf((v2 - v1) * rs)), g2 = 1.f - g1;
            const unsigned p1 = __hip_atomic_fetch_add(lcnt + e1, 1u, __ATOMIC_RELAXED, __HIP_MEMORY_SCOPE_WORKGROUP), p2 = __hip_atomic_fetch_add(lcnt + 8 + e2, 1u, __ATOMIC_RELAXED, __HIP_MEMORY_SCOPE_WORKGROUP);
            LAS int* rr = rrow + (F.wave * 64 + nrow) * 8; rr[0] = m; rr[1] = e1; rr[2] = e2; rr[3] = (int)p1; rr[4] = (int)p2; rr[5] = (int)__float_as_uint(g1);
        }
        ++nrow;
    }
    __syncthreads();
    if (F.tid < 16) lbase[F.tid] = atomicAdd(cnt + 64 * F.tid, lcnt[F.tid]);
    __syncthreads();
    for (int i = F.lane; i < nrow; i += 64) { const LAS int* rr = rrow + (F.wave * 64 + i) * 8; const int m = rr[0], e1 = rr[1], e2 = rr[2]; const float g1 = __uint_as_float((unsigned)rr[5]);
        const size_t q1 = (size_t)e1 * M + lbase[e1] + (unsigned)rr[3], q2 = (size_t)(8 + e2) * M + lbase[8 + e2] + (unsigned)rr[4];
        lidx[q1] = m; lgate[q1] = g1; lidx[q2] = m; lgate[q2] = 1.f - g1; }
    __syncthreads();
    LAS float* scr = (LAS float*)(F.lds + RING_OFF + F.wave * 8448);
    constexpr int I_13 = 16 * (2 * FFE / 32), I_2 = (FFE / 64) * 32, I_E = I_13 + I_2;
    for (int it = gw; it < NEXP * I_E; it += NGW) { const int e = it / I_E; int r = it % I_E;
        if (r < I_13) { conv_up8(F.in[17] + (size_t)e * DM * FFE, F.in[18] + (size_t)e * DM * FFE, FFE, F.in[2] + DM, SW1, F.ws + R_W13E + e * SZ_W13E, r, scr, F.lane); continue; } r -= I_13;
        conv_std8(F.in[19] + (size_t)e * FFE * DM, DM, DM, SW2, F.ws + R_W2E + e * SZ_W2E, FFE, r, scr, F.lane); }
}
__device__ __forceinline__ void moe_table(const Frame& F) {
    volatile LAS int* tb = (volatile LAS int*)(F.lds + MISC_OFF + 64);
    if (F.tid == 0) { int acc = 0;
        for (int g = 0; g < 16; ++g) { const int c = (int)__hip_atomic_load(F.ctl + CW_CNT + 64 * g, RLX_AGENT); tb[g] = acc; tb[32 + g] = c; acc += (c + 255) >> 8; }
        tb[16] = acc; }
    __syncthreads();
}
constexpr int PH_PER_LAYER = 13, N_PHASES = 1 + 2 * PH_PER_LAYER;
struct Args { const float* in[20]; float* out; unsigned char* ws; int ph_lo, ph_hi; };
__global__ void __launch_bounds__(NTHR, 2) mk_fwd(Args args) {
    extern __shared__ __attribute__((aligned(16))) unsigned char lds[];
    Frame F;
    F.lds = (LAS unsigned char*)lds; F.MISC = (volatile LAS unsigned*)(F.lds + MISC_OFF);
    F.tid = 0; F.lane = 0; F.wave = __builtin_amdgcn_readfirstlane(threadIdx.x >> 6);
    F.G = gridDim.x; { const int bx = blockIdx.x; F.vcu = (F.G % 8 == 0) ? (bx % 8) * (F.G / 8) + bx / 8 : bx; }
    F.ws = args.ws; F.ctl = (unsigned*)(args.ws + WS_CTL); F.out = args.out;
    F.in = args.in;
    for (int u = threadIdx.x; u < (LDS_BYTES - LDSCTL_OFF) / 4; u += NTHR) ((LAS unsigned*)(F.lds + LDSCTL_OFF))[u] = 0u;
    __syncthreads();
    XcdBarrier bar; bar.bar = F.ctl + CW_BAR; bar.x = 0; bar.st = nullptr;
    if (MK_N_LAUNCHES == 1) bar = xcd_barrier_post(F.ctl + CW_BAR, F.MISC + 8);
    const int lo = args.ph_lo, hi = args.ph_hi;
#define IN(k) (lo <= (k) && (k) < hi)
#define SEAM(k) do { if ((k) + 1 < hi) { if (MK_N_LAUNCHES == 1) xcd_barrier(bar); } } while (0)

    if (IN(0)) { p_prologue(F); SEAM(0); }

    for (int l = 0; l < 2; ++l) {
        const int pb = 1 + PH_PER_LAYER * l;
#define PHASE_LOCALS const Frame P = phase_frame(F); int ll = l; LAUNDER_S(ll); \
        const unsigned char* wl = P.ws + WS_W + ll * SZ_WL; bf16* x16 = (bf16*)(P.ws + WS_X16); float* ssqb = (float*)(P.ws + WS_SSQ); \
        const float* ssq_attn = ssqb + (ll == 0 ? 0 : 2 * 4 * M); float* ssq_ffn = ssqb + 4 * M; LAS float* xch = (LAS float*)(P.lds + XCH_OFF); (void)xch; LAS unsigned char* ring = P.lds + RING_OFF; const int bx = (int)blockIdx.x; \
        (void)wl; (void)x16; (void)ssq_attn; (void)ssq_ffn; (void)ring; (void)bx
        if (IN(pb + 0)) {
            PHASE_LOCALS;
            pg8::StaticOrder S; S.init(x16, wl + OFF_WA, M, NA, P.G, bx);
            EpiA E{(GAS bf16*)(P.ws + R_BUFA), (const GAS float*)ssq_attn, (const GAS float*)(P.in[4] + ll * 64), (const GAS float*)(P.in[5] + ll * 64)};
            pg8::gemm_phase<DM>(ring, S, E, P.wave); SEAM(pb + 0); }
                if (IN(pb + 1)) { p_attn_mfma(F); p_conv(F, l); SEAM(pb + 1); }
        if (IN(pb + 2)) {
            PHASE_LOCALS;
            pg8::StaticOrder S; S.init(x16, wl + OFF_WC, M, NC, P.G, bx);
            const float* misc = (const float*)(P.ws + WS_MISC);
            EpiC E{(GAS bf16*)(P.ws + R_HG), (const GAS float*)ssq_attn, (const GAS float*)(misc + MI_LBA + ll * 768)};
            pg8::gemm_phase<DM>(ring, S, E, P.wave); SEAM(pb + 2); }
        if (IN(pb + 3)) { p_hgrn1_mfma(F); SEAM(pb + 3); }
        if (IN(pb + 4)) { p_hgrn2_mfma(F, l); SEAM(pb + 4); }
        if (IN(pb + 6)) {
            { PHASE_LOCALS;
              pg8::GateOrder SG; SG.mo.init(P.ws + R_MIX, wl + OFF_WP, M, DM, P.G, bx); SG.A = (const char*)x16; SG.Bt = (const char*)(wl + OFF_WG);
              EpiG EG{(GAS unsigned char*)(P.ws + R_GATES), (const GAS float*)ssq_attn};
              pg8::gemm_phase<DM>(ring, SG, EG, P.wave); }
            { PHASE_LOCALS;
              pg8::StaticOrder S; S.init(P.ws + R_MIX, wl + OFF_WP, M, DM, P.G, bx);
              EpiM E{(GAS bf16*)(P.ws + R_MERGED), (const GAS unsigned char*)(P.ws + R_GATES)};
              pg8::gemm_phase<KP>(ring, S, E, P.wave); }
            SEAM(pb + 6); }
        if (IN(pb + 7)) {
            PHASE_LOCALS;
            pg8::StaticOrder S; S.init(P.ws + R_MERGED, wl + OFF_WO, M, DM, P.G, bx);
            EpiO E{(GAS bf16*)x16, (GAS float*)ssq_ffn, xch};
            pg8::gemm_phase<DM>(ring, S, E, P.wave); SEAM(pb + 7); }
        if (l == 0) {
            if (IN(pb + 8)) {
                PHASE_LOCALS;
                pg8::StaticOrder S; S.init(x16, P.ws + WS_W13, M, 2 * FFD, P.G, bx);
                EpiU E{(GAS bf16*)(P.ws + R_HID), (const GAS float*)ssq_ffn};
                pg8::gemm_phase<DM>(ring, S, E, P.wave); SEAM(pb + 8); }
            if (IN(pb + 9)) {
                PHASE_LOCALS;
                pg8::StaticOrder S; S.init(P.ws + R_HID, P.ws + WS_W2, M, DM, P.G, bx);
                EpiO E{(GAS bf16*)x16, (GAS float*)(ssqb + 2 * 4 * M), xch};
                pg8::gemm_phase<FFD>(ring, S, E, P.wave); SEAM(pb + 9); }
        } else {
            if (IN(pb + 8)) { p_route(F); SEAM(pb + 8); }
            if (IN(pb + 9)) {
                PHASE_LOCALS;
                volatile LAS int* tb = (volatile LAS int*)(P.lds + MISC_OFF + 64);
                const int* lidx = (const int*)(P.ws + R_LIST);
                moe_table(P);
                MoeUpOrder S; S.A = (const char*)(P.ws + R_X8); S.Bt = (const char*)(P.ws + R_W13E); S.bstride = SZ_W13E; S.idx = lidx; S.tb = tb; S.nN = 2 * FFE / 256; S.ubase = 0; S.nwg = tb[16] * S.nN; S.lim = S.nwg; S.G = P.G; S.c = bx;
                EpiMU E{(GAS unsigned char*)(P.ws + R_HIDE), tb};
                pg8::gemm_phase<DM, EpiMU, MoeUpOrder, DM, true>(ring, S, E, P.wave); SEAM(pb + 9); }
#pragma unroll 1
            for (int slot = 0; slot < 2; ++slot) {
                if (IN(pb + 10 + slot)) {
                    PHASE_LOCALS; int sl = slot; LAUNDER_S(sl);
                    volatile LAS int* tb = (volatile LAS int*)(P.lds + MISC_OFF + 64);
                    const int* lidx = (const int*)(P.ws + R_LIST); const float* lgate = (const float*)(P.ws + R_LIST) + 16 * M;
                    moe_table(P);
                    MoeDownOrder S; S.A = (const char*)(P.ws + R_HIDE); S.Bt = (const char*)(P.ws + R_W2E); S.bstride = SZ_W2E; S.idx = nullptr; S.tb = tb; S.nN = DM / 256; S.ubase = tb[8 * sl] * S.nN; S.nwg = (tb[8 * sl + 8] - tb[8 * sl]) * S.nN; S.G = P.G; S.c = bx;
                    S.lim = S.nwg;
                    EpiMD E{(GAS bf16*)x16, (sl == 0) ? (GAS float*)nullptr : (GAS float*)P.out, (const GAS int*)lidx, (const GAS float*)lgate, tb};
                    pg8::gemm_phase<FFE, EpiMD, MoeDownOrder, FFE, true>(ring, S, E, P.wave);
                    SEAM(pb + 10 + slot); }
            }
        }
    }
#undef IN
#undef SEAM
}


extern "C" void kernel_launch(void* const* d_in, const int* in_sizes, int n_in, void* d_out, int out_size, void* d_ws, size_t ws_size, hipStream_t stream) {
    static int grid = 0;
    if (grid == 0) {
        if (n_in != 20 || in_sizes[0] != M * DM || out_size != M * DM || ws_size < WS_TOTAL) { fprintf(stderr, "kernel_launch: unexpected shapes / workspace (%d inputs, in0 %d, out %d, ws %zu, need %zu); nothing launched\n", n_in, n_in > 0 ? in_sizes[0] : -1, out_size, ws_size, (size_t)WS_TOTAL); grid = -1; return; }
        int dev = 0, cus = 0, per_cu = 0;
        if (hipGetDevice(&dev) != hipSuccess || hipDeviceGetAttribute(&cus, hipDeviceAttributeMultiprocessorCount, dev) != hipSuccess) { grid = -1; return; }
        if (hipFuncSetAttribute((const void*)mk_fwd, hipFuncAttributeMaxDynamicSharedMemorySize, LDS_BYTES) != hipSuccess) { fprintf(stderr, "kernel_launch: hipFuncSetAttribute failed\n"); grid = -1; return; }
        if (hipOccupancyMaxActiveBlocksPerMultiprocessor(&per_cu, (const void*)mk_fwd, NTHR, LDS_BYTES) != hipSuccess || per_cu < 1) { fprintf(stderr, "kernel_launch: occupancy query reports %d workgroups per CU\n", per_cu); }
        (void)hipGetLastError();
        grid = cus;
    }
    if (grid < 0) return;
    if (hipMemsetAsync((char*)d_ws + WS_CTL, 0, CTL_ZERO_BYTES, stream) != hipSuccess) return;
    Args a{};
    for (int i = 0; i < 20; ++i) a.in[i] = (const float*)d_in[i];
    a.out = (float*)d_out; a.ws = (unsigned char*)d_ws;
#if MK_N_LAUNCHES == 1
    a.ph_lo = 0; a.ph_hi = N_PHASES;
    hipLaunchKernelGGL(mk_fwd, dim3(grid), dim3(NTHR), LDS_BYTES, stream, a);
#else
    for (int p = 0; p < N_PHASES; ++p) {
        if (p >= 1 + 10 && p < 1 + PH_PER_LAYER) continue;
        a.ph_lo = p; a.ph_hi = p + 1;
        hipLaunchKernelGGL(mk_fwd, dim3(grid), dim3(NTHR), LDS_BYTES, stream, a);
    }
#endif
}
```

```cpp
#include <hip/hip_runtime.h>
#include <cstdio>
#include <cstdint>

#ifndef MK_N_LAUNCHES
#define MK_N_LAUNCHES 1
#endif

namespace pg8 {
#define PG8_LAS __attribute__((address_space(3)))
typedef unsigned short bf16_t;
typedef short bf16x8 __attribute__((ext_vector_type(8)));
typedef float f32x4 __attribute__((ext_vector_type(4)));
typedef unsigned u32x4 __attribute__((ext_vector_type(4)));
typedef unsigned u32x2 __attribute__((ext_vector_type(2)));
typedef int v8i __attribute__((ext_vector_type(8)));
typedef int v4i __attribute__((ext_vector_type(4)));
template <bool FP8> struct Frag { bf16x8 k[2]; };
template <> struct Frag<true> { v8i v; };
constexpr int BM = 256, BK = 64, HALF = 128, HTB = HALF * BK * 2, STAGE_BYTES = 8 * HTB, NXCD = 8, WGM = 4;

__host__ __device__ __forceinline__ int lds_byte(int r, int c) { const int st = (r >> 4) * 2 + (c >> 5), rr = r & 15, cc = c & 31, ob = rr * 64 + cc * 2; return st * 1024 + (ob ^ (((ob >> 9) & 1) << 5)); }
__host__ __device__ __forceinline__ void stage_rc(int b, int& R, int& C) { const int st = b / 1024, sb = b % 1024, swz = sb ^ (((sb >> 9) & 1) << 5); R = (st >> 1) * 16 + swz / 64; C = (st & 1) * 32 + (swz % 64) / 2; }

__device__ __forceinline__ int lane_now() { int l; asm volatile("v_mbcnt_lo_u32_b32 %0, -1, 0\n\tv_mbcnt_hi_u32_b32 %0, -1, %0" : "=v"(l)); return l; }
struct Unit { int pm, pn, g; };

typedef float f32x2_t __attribute__((ext_vector_type(2))); typedef __bf16 bf16x2_t __attribute__((ext_vector_type(2)));
__device__ __forceinline__ unsigned cvt_pk_bf16(float lo, float hi) { f32x2_t v = {lo, hi}; bf16x2_t b = __builtin_convertvector(v, bf16x2_t); return __builtin_bit_cast(unsigned, b); }
__device__ __forceinline__ float bf_lo(unsigned u) { return __uint_as_float(u << 16); }
__device__ __forceinline__ float bf_hi(unsigned u) { return __uint_as_float(u & 0xffff0000u); }

__device__ __forceinline__ int xcd_remap(int L, int nwg) { const int q = nwg / NXCD, r = nwg % NXCD, xcd = L % NXCD, off = L / NXCD; return (xcd < r ? xcd * (q + 1) : r * (q + 1) + (xcd - r) * q) + off; }
__device__ __forceinline__ void tile_decode(int w, int nM, int nN, int& pm, int& pn) { const int nig = WGM * nN, gid = w / nig, fm = gid * WGM, gsz = (nM - fm) < WGM ? (nM - fm) : WGM; pm = fm + ((w % nig) % gsz); pn = (w % nig) / gsz; }

struct StaticOrder {
    static constexpr bool GATHER = false;
    const char* A; const char* Bt; int nM, nN, nwg, G, c;
    __device__ __forceinline__ void init(const void* A_, const void* Bt_, int M, int N, int G_, int c_) { A = (const char*)A_; Bt = (const char*)Bt_; nM = M / BM; nN = N / BM; nwg = nM * nN; G = G_; c = c_; }
    __device__ __forceinline__ bool next(int i, Unit& u) const { const long L = (long)i * G + c; if (L >= nwg) return false; const int w = xcd_remap((int)L, nwg); tile_decode(w, nM, nN, u.pm, u.pn); u.g = 0; return true; }
    __device__ __forceinline__ const char* abase(const Unit& u, size_t tstep) const { return A + (size_t)u.pm * tstep; }
    __device__ __forceinline__ const char* bbase(const Unit& u, size_t tstep) const { return Bt + (size_t)u.pn * tstep; }
    __device__ __forceinline__ void avoff(const Unit&, int, int, unsigned (&)[2][2]) const {}
    __device__ __forceinline__ void avoff_lds(const Unit&, int, int, unsigned (&)[2][2], const PG8_LAS int*) const {}
    __device__ __forceinline__ void idx_prefetch(const Unit&, int, PG8_LAS int*) const {}
};

struct GateOrder {
    static constexpr bool GATHER = false;
    StaticOrder mo; const char* A; const char* Bt;
    __device__ __forceinline__ bool next(int i, Unit& u) const { Unit mu; if (!mo.next(i / 3, mu)) return false; u.pm = mu.pm; u.pn = 4 * (i % 3) + mu.pn; u.g = 0; return true; }
    __device__ __forceinline__ const char* abase(const Unit& u, size_t tstep) const { return A + (size_t)u.pm * tstep; }
    __device__ __forceinline__ const char* bbase(const Unit& u, size_t tstep) const { return Bt + (size_t)u.pn * tstep; }
    __device__ __forceinline__ void avoff(const Unit&, int, int, unsigned (&)[2][2]) const {}
    __device__ __forceinline__ void avoff_lds(const Unit&, int, int, unsigned (&)[2][2], const PG8_LAS int*) const {}
    __device__ __forceinline__ void idx_prefetch(const Unit&, int, PG8_LAS int*) const {}
};
template <int K, class Epi, class Sched, int LD = K, bool FP8 = false>
__device__ __forceinline__ void gemm_phase(PG8_LAS unsigned char* lds, const Sched& S, const Epi& E, const int wid) {
    constexpr bool GATHER = Sched::GATHER;
    int lane; asm volatile("v_mbcnt_lo_u32_b32 %0, -1, 0\n\tv_mbcnt_hi_u32_b32 %0, -1, %0" : "=v"(lane));
    const int tid = wid * 64 + lane, wr = wid >> 2, wc = wid & 3, fr = lane & 15, fq = lane >> 4;
    constexpr int EB = FP8 ? 1 : 2, nt = K * EB / 128;
    unsigned voffB[2]; unsigned vA[2][2];
#pragma unroll
    for (int i = 0; i < 2; ++i) { int R, C; stage_rc(tid * 16 + i * 8192, R, C); voffB[i] = (unsigned)(R * LD * EB + C * 2); vA[0][i] = voffB[i]; vA[1][i] = voffB[i]; }
    constexpr size_t kstep = (size_t)(BK * 2);
    constexpr size_t hstep = (size_t)HALF * LD * EB;
    constexpr size_t tstep = 2 * hstep;
    const unsigned ldsw = (unsigned)wid * 1024u;
    const int fcol = fq * 8;
    const int aoff = lds_byte(wr * 64 + fr, fcol), boff = lds_byte(wc * 32 + fr, fcol);
#define PG8_SA(b, h) (((b) * 2 + (h)) * HTB)
#define PG8_SB(b, h) ((4 + (b) * 2 + (h)) * HTB)
#define PG8_STAGE(bufoff, gbase, voff) do { _Pragma("unroll") for (int _i = 0; _i < 2; ++_i) \
        __builtin_amdgcn_global_load_lds((const unsigned*)((const char*)(gbase) + (voff)[_i]), (PG8_LAS unsigned*)(lds + (bufoff) + ldsw + _i * 8192), 16, 0, 0); } while (0)
#define PG8_STAGE_B(bufoff, gbase, h) PG8_STAGE(bufoff, (gbase) + (h) * hstep, voffB)
#define PG8_STAGE_A(bufoff, gbase, h) do { if constexpr (GATHER) { PG8_STAGE(bufoff, gbase, vA[h]); } else { PG8_STAGE(bufoff, (gbase) + (h) * hstep, vA[0]); } } while (0)
#define PG8_LDF(dst, p_) do { if constexpr (FP8) { const v4i lo_ = *(const PG8_LAS v4i*)(p_), hi_ = *(const PG8_LAS v4i*)((p_) + 1024); dst.v = __builtin_shufflevector(lo_, hi_, 0, 1, 2, 3, 4, 5, 6, 7); } \
        else { dst.k[0] = *(const PG8_LAS bf16x8*)(p_); dst.k[1] = *(const PG8_LAS bf16x8*)((p_) + 1024); } } while (0)
#define PG8_LDA(dst, b, h) do { _Pragma("unroll") for (int m = 0; m < 4; ++m) PG8_LDF(dst[m], lds + PG8_SA(b, h) + aoff + m * 2048); } while (0)
#define PG8_LDB(dst, b, h) do { _Pragma("unroll") for (int n = 0; n < 2; ++n) PG8_LDF(dst[n], lds + PG8_SB(b, h) + boff + n * 2048); } while (0)
#define PG8_MMA(ai, bj, At, Bt) do { __builtin_amdgcn_s_setprio(1); _Pragma("unroll") for (int m = 0; m < 4; ++m) _Pragma("unroll") for (int n = 0; n < 2; ++n) { \
        if constexpr (FP8) asm volatile("v_mfma_scale_f32_16x16x128_f8f6f4 %0, %1, %2, %0, %3, %3 op_sel_hi:[0,0,0]" : "+v"(acc[ai][bj][m][n]) : "v"(Bt[n].v), "v"(At[m].v), "v"(0x7f7f7f7f));   \
        else { _Pragma("unroll") for (int k = 0; k < 2; ++k) acc[ai][bj][m][n] = __builtin_amdgcn_mfma_f32_16x16x32_bf16(Bt[n].k[k], At[m].k[k], acc[ai][bj][m][n], 0, 0, 0); } } \
        __builtin_amdgcn_s_setprio(0); } while (0)
#define PG8_WAIT_V(n) asm volatile("s_waitcnt vmcnt(" #n ")" ::: "memory")
#define PG8_WAIT_L(n) asm volatile("s_waitcnt lgkmcnt(" #n ")" ::: "memory")
#define PG8_BAR __builtin_amdgcn_s_barrier()
#define PG8_SCHED __builtin_amdgcn_sched_barrier(0)
    Unit cur, nxt; int ui = 0;
    if (!S.next(0, cur)) return;
    f32x4 acc[2][2][4][2];
#pragma unroll
    for (int a = 0; a < 2; ++a)
#pragma unroll
        for (int b = 0; b < 2; ++b)
#pragma unroll
            for (int m = 0; m < 4; ++m)
#pragma unroll
                for (int n = 0; n < 2; ++n) acc[a][b][m][n] = (f32x4){0.f, 0.f, 0.f, 0.f};
    Frag<FP8> At[4], B0[2], B1[2];
    const char* cA = S.abase(cur, tstep); const char* cB = S.bbase(cur, tstep);
    if constexpr (GATHER) S.avoff(cur, wid, LD * EB, vA);
    PG8_STAGE_B(PG8_SB(0, 0), cB, 0); PG8_STAGE_B(PG8_SB(0, 1), cB, 1); PG8_STAGE_A(PG8_SA(0, 0), cA, 0); PG8_STAGE_A(PG8_SA(0, 1), cA, 1);
    if (wr == 1) PG8_BAR;
    PG8_WAIT_V(2); PG8_BAR;
    PG8_STAGE_B(PG8_SB(1, 0), cB + kstep, 0); PG8_STAGE_A(PG8_SA(1, 0), cA + kstep, 0); PG8_STAGE_B(PG8_SB(1, 1), cB + kstep, 1);
    PG8_WAIT_V(6); PG8_BAR;
    for (;;) {
        if constexpr (Epi::PRE) E.prefetch(cur, wid, lds + 131072 + 10240);
        const bool has_next = S.next(ui + 1, nxt);
        if constexpr (GATHER) { if (has_next) S.idx_prefetch(nxt, wid, (PG8_LAS int*)(lds + 131072 + 8192) + ((ui + 1) & 1) * 256); }
        const char* nA = has_next ? S.abase(nxt, tstep) : cA; const char* nB = has_next ? S.bbase(nxt, tstep) : cB;
#pragma unroll 1
        for (int t = 0; t < nt; t += 2) {
            const bool last = (t == nt - 2);
            if constexpr (Epi::MID) { if (E.is_mid(t)) { PG8_SCHED; E.mid(acc, cur, t, wr, wc, fr, fq); PG8_SCHED; } }
            const char* a1 = cA + (size_t)(t + 1) * kstep;
            const char* a2 = last ? nA : cA + (size_t)(t + 2) * kstep; const char* b2 = last ? nB : cB + (size_t)(t + 2) * kstep;
            const char* a3 = a2 + kstep; const char* b3 = b2 + kstep;
            PG8_LDB(B0, 0, 0); PG8_LDB(B1, 0, 1); PG8_SCHED; PG8_LDA(At, 0, 0); PG8_STAGE_A(PG8_SA(1, 1), a1, 1);
            PG8_WAIT_V(8); PG8_WAIT_L(0); PG8_BAR; PG8_MMA(0, 0, At, B0); PG8_MMA(0, 1, At, B1); PG8_BAR; PG8_SCHED;
            if constexpr (GATHER) { if (last && has_next) S.avoff_lds(nxt, wid, LD * EB, vA, (const PG8_LAS int*)(lds + 131072 + 8192) + ((ui + 1) & 1) * 256); }
            PG8_LDA(At, 0, 1); PG8_STAGE_B(PG8_SB(0, 0), b2, 0); PG8_STAGE_B(PG8_SB(0, 1), b2, 1); PG8_STAGE_A(PG8_SA(0, 0), a2, 0);
            PG8_WAIT_V(8); PG8_WAIT_L(0); PG8_BAR; PG8_MMA(1, 0, At, B0); PG8_MMA(1, 1, At, B1); PG8_BAR; PG8_SCHED;
            PG8_LDB(B0, 1, 0); PG8_LDB(B1, 1, 1); PG8_SCHED; PG8_LDA(At, 1, 0); PG8_STAGE_A(PG8_SA(0, 1), a2, 1);
            PG8_WAIT_V(8); PG8_WAIT_L(0); PG8_BAR; PG8_MMA(0, 0, At, B0); PG8_MMA(0, 1, At, B1); PG8_BAR; PG8_SCHED;
            PG8_LDA(At, 1, 1); PG8_STAGE_B(PG8_SB(1, 0), b3, 0); PG8_STAGE_B(PG8_SB(1, 1), b3, 1); PG8_STAGE_A(PG8_SA(1, 0), a3, 0);
            PG8_WAIT_V(8); PG8_WAIT_L(0); PG8_BAR; PG8_MMA(1, 0, At, B0); PG8_MMA(1, 1, At, B1); PG8_BAR; PG8_SCHED;
        }
        if (wr == 0) PG8_BAR;
        if constexpr (FP8) asm volatile("s_nop 15\n\ts_nop 15" ::: "memory");
        E(acc, cur, wr, wc, fr, fq);
        if (!has_next) break;
#pragma unroll
        for (int a = 0; a < 2; ++a)
#pragma unroll
            for (int b = 0; b < 2; ++b)
#pragma unroll
                for (int m = 0; m < 4; ++m)
#pragma unroll
                    for (int n = 0; n < 2; ++n) acc[a][b][m][n] = (f32x4){0.f, 0.f, 0.f, 0.f};
        cur = nxt; cA = nA; cB = nB; ++ui;
        if (wr == 1) PG8_BAR;
    }
    PG8_WAIT_V(0);
    PG8_BAR;
#undef PG8_SA
#undef PG8_SB
#undef PG8_STAGE
#undef PG8_STAGE_A
#undef PG8_STAGE_B
#undef PG8_LDA
#undef PG8_LDF
#undef PG8_LDB
#undef PG8_MMA
#undef PG8_WAIT_V
#undef PG8_WAIT_L
#undef PG8_BAR
#undef PG8_SCHED
}
}

constexpr int NWAVES = 8, NTHR = 512;
constexpr int BATCH = 8, SEQ = 4096, DM = 1024, M = BATCH * SEQ;
constexpr int INCOLS = 10752, NA = 4608, NC = 3072, NG = 3072, KP = 1792;
constexpr int NAO = 3840;
constexpr int FFD = 2816, FFE = 3584, NEXP = 8;
constexpr int HG_H = 6, HG_D = 128, HSEG = 16, HSEGLEN = SEQ / HSEG;
constexpr float RMS_EPS = 1e-6f;
constexpr float QSCALE = 0.125f * 1.4426950408889634f;

constexpr size_t MiB = 1u << 20;
constexpr size_t WS_CTL = 0, CTL_ZERO_BYTES = 1 * MiB;
constexpr size_t WS_MISC = 1 * MiB;
constexpr size_t WS_W = 2 * MiB;
constexpr size_t SZ_WA = (size_t)NA * DM * 2, SZ_WC = (size_t)NC * DM * 2, SZ_WG = (size_t)NG * DM * 2, SZ_WP = (size_t)DM * KP * 2, SZ_WO = (size_t)DM * DM * 2;
constexpr size_t SZ_WL = SZ_WA + SZ_WC + SZ_WG + SZ_WP + SZ_WO;
constexpr size_t OFF_WA = 0, OFF_WC = SZ_WA, OFF_WG = OFF_WC + SZ_WC, OFF_WP = OFF_WG + SZ_WG, OFF_WO = OFF_WP + SZ_WP;
constexpr size_t WS_W13 = WS_W + 2 * SZ_WL, SZ_W13 = (size_t)2 * FFD * DM * 2, WS_W2 = WS_W13 + SZ_W13, SZ_W2 = (size_t)DM * FFD * 2;
constexpr size_t WS_X16 = 72 * MiB;
static_assert(WS_W2 + SZ_W2 <= WS_X16, "weights fit");
constexpr size_t WS_R = 136 * MiB;
constexpr size_t R_BUFA = WS_R, R_MIX = WS_R + 288 * MiB, R_MERGED = WS_R + 400 * MiB, WS_END = WS_R + 464 * MiB;
constexpr size_t R_HG = R_BUFA, R_OLOC = R_BUFA + 192 * MiB, R_QD = R_BUFA + 240 * MiB;
constexpr size_t R_FST = R_MERGED, R_DST = R_MERGED + 48 * MiB;
constexpr size_t R_GATES = R_BUFA;
constexpr size_t R_HID = WS_R;
constexpr size_t R_W13E = WS_R, SZ_W13E = (size_t)2 * FFE * DM, R_W2E = WS_R + 56 * MiB, SZ_W2E = (size_t)DM * FFE;
constexpr size_t R_HIDE = WS_R + 84 * MiB;
constexpr float SW1 = 64.f, SW2 = 128.f, SH = 8.f;
constexpr size_t R_X8 = WS_R + 336 * MiB;
constexpr int MOE_MAXROWS = M + NEXP * 256;
constexpr size_t R_LIST = WS_R + 328 * MiB;
static_assert(R_HIDE + 2 * (size_t)MOE_MAXROWS * FFE <= R_LIST && R_LIST + 3 * 16 * (size_t)M * 4 <= R_X8 && R_X8 + (size_t)M * DM <= WS_END, "moe map");
constexpr int MI_RGW = 0;
constexpr int MI_LBA = 8192;
constexpr int MI_QKG = MI_LBA + 1536;
constexpr int CW_TMO = 0, CW_CODE = 1, CW_BAR = 4096, CW_CNT = 8192  ;
constexpr size_t WS_SSQ = WS_END, SZ_SSQ = (size_t)M * 16, WS_TOTAL = WS_SSQ + 3 * SZ_SSQ;

constexpr int RING_OFF = 0, RING_BYTES = 131072;
constexpr int LDSCTL_OFF = RING_BYTES, MISC_OFF = LDSCTL_OFF + 320;
constexpr int XCH_OFF = RING_BYTES + 1024;
constexpr int LDS_BYTES = 147456;
constexpr int SSQL_OFF = RING_BYTES + 10240;
#define EPI_SSQ_LDS (this->sl)

#define GAS __attribute__((address_space(1)))
#define LAS __attribute__((address_space(3)))
typedef unsigned short bf16;
typedef unsigned v4u __attribute__((ext_vector_type(4)));
typedef unsigned v2u __attribute__((ext_vector_type(2)));
typedef float f32x4 __attribute__((ext_vector_type(4)));
typedef GAS unsigned gu32;
#define RLX_AGENT __ATOMIC_RELAXED, __HIP_MEMORY_SCOPE_AGENT
#define LDS_WAIT() asm volatile("s_waitcnt lgkmcnt(0)" ::: "memory")
#define VM_WAIT() asm volatile("s_waitcnt vmcnt(0)" ::: "memory")
__device__ __forceinline__ unsigned f2bf(float f) { unsigned u = __builtin_bit_cast(unsigned, f); return (u + 0x7fffu + ((u >> 16) & 1u)) >> 16; }
__device__ __forceinline__ unsigned pk2(float lo, float hi) { return pg8::cvt_pk_bf16(lo, hi); }
__device__ __forceinline__ float bflo(unsigned u) { return __uint_as_float(u << 16); }
__device__ __forceinline__ float bfhi(unsigned u) { return __uint_as_float(u & 0xffff0000u); }
__device__ __forceinline__ unsigned pk4_fp8(float a, float b, float c, float d) {
    a = __builtin_amdgcn_fmed3f(a, -448.f, 448.f); b = __builtin_amdgcn_fmed3f(b, -448.f, 448.f); c = __builtin_amdgcn_fmed3f(c, -448.f, 448.f); d = __builtin_amdgcn_fmed3f(d, -448.f, 448.f);
    int w = __builtin_amdgcn_cvt_pk_fp8_f32(a, b, 0, false); w = __builtin_amdgcn_cvt_pk_fp8_f32(c, d, w, true); return (unsigned)w; }
__device__ __forceinline__ float fast_rcp(float x) { return __builtin_amdgcn_rcpf(x); }
__device__ __forceinline__ float fast_exp(float x) { return __builtin_amdgcn_exp2f(x * 1.4426950408889634f); }
__device__ __forceinline__ float fast_log(float x) { return __builtin_amdgcn_logf(x) * 0.6931471805599453f; }
__device__ __forceinline__ float sigmoid_f(float x) { return fast_rcp(1.f + fast_exp(-x)); }
__device__ __forceinline__ float silu_f(float x) { return x * sigmoid_f(x); }

#define XB_TMO      128
#define XB_XCNT(j)  (256  + 64 * (j))
#define XB_XSUB(j)  (1280 + 64 * (j))
#define XB_XGEN(j)  (2304 + 64 * (j))
#define XB_TOP      3328
#define XB_TOPGEN   3392
#define XCD_BAR_WORDS 3456
#define XB_SPIN_CAP (1u << 18)
__device__ __forceinline__ unsigned xb_ld(unsigned* p)              { return __hip_atomic_load(p, __ATOMIC_RELAXED, __HIP_MEMORY_SCOPE_AGENT); }
__device__ __forceinline__ unsigned xb_add(unsigned* p, unsigned v) { return __hip_atomic_fetch_add(p, v, __ATOMIC_RELAXED, __HIP_MEMORY_SCOPE_AGENT); }
__device__ __forceinline__ unsigned xb_xcc_id() { return (unsigned)__builtin_amdgcn_s_getreg((3 << 11) | 20) & 0xFu; }
#define XB_SPIN(cond, bar) do { unsigned _sp = 0; while (cond) { __builtin_amdgcn_s_sleep(1); \
    if ((++_sp & 255u) == 0u) { if (xb_ld(&(bar)[XB_TMO])) break; if (_sp > XB_SPIN_CAP) { atomicAdd(&(bar)[XB_TMO], 1u); break; } } } } while (0)
struct XcdBarrier { unsigned* bar; unsigned x; volatile LAS unsigned* st; };
__device__ __forceinline__ XcdBarrier xcd_barrier_post(unsigned* bar, volatile LAS unsigned* st) {
    XcdBarrier b; b.bar = bar; b.x = xb_xcc_id(); b.st = st;
    if (threadIdx.x == 0) (void)xb_add(&bar[XB_XCNT(b.x)], 1u);
    return b;
}
__device__ __forceinline__ void xcd_barrier_complete(unsigned* bar, unsigned x, unsigned& nloc, unsigned& nx) {
    const unsigned G = gridDim.x * gridDim.y * gridDim.z;
    unsigned sum, cnt, mine, sp = 0u;
    for (;;) {
        sum = 0u; cnt = 0u; mine = 0u;
#pragma unroll
        for (unsigned j = 0; j < 16; ++j) { const unsigned c = xb_ld(&bar[XB_XCNT(j)]); sum += c; cnt += (c > 0u) ? 1u : 0u; mine = (j == x) ? c : mine; }
        if (sum == G) break;
        __builtin_amdgcn_s_sleep(1);
        if ((++sp & 255u) == 0u) { if (xb_ld(&bar[XB_TMO])) break; if (sp > XB_SPIN_CAP) { atomicAdd(&bar[XB_TMO], 1u); break; } }
    }
    nloc = mine > 0u ? mine : 1u; nx = cnt > 0u ? cnt : 1u;
}
__device__ __forceinline__ void xcd_barrier(const XcdBarrier& b) {
    asm volatile("s_waitcnt vmcnt(0)" ::: "memory");
    __syncthreads();
    if (threadIdx.x == 0) {
        unsigned* bar = b.bar;
        __builtin_amdgcn_s_waitcnt(0);
        unsigned nloc = b.st[0], nx = b.st[1];
        if (nloc == 0u) { xcd_barrier_complete(bar, b.x, nloc, nx); b.st[0] = nloc; b.st[1] = nx; }
        const unsigned old = xb_add(&bar[XB_XSUB(b.x)], 1u);
        const unsigned gen = old / nloc;
        if (old + 1u == (gen + 1u) * nloc) {
            __builtin_amdgcn_fence(__ATOMIC_RELEASE, "agent");
            asm volatile("s_waitcnt vmcnt(0)" ::: "memory");
            const unsigned og = xb_add(&bar[XB_TOP], 1u);
            const unsigned tg = og / nx;
            if (og + 1u == (tg + 1u) * nx) xb_add(&bar[XB_TOPGEN], 1u);
            else XB_SPIN(xb_ld(&bar[XB_TOPGEN]) == tg, bar);
            __builtin_amdgcn_fence(__ATOMIC_ACQUIRE, "agent");
            xb_add(&bar[XB_XGEN(b.x)], 1u);
            asm volatile("s_waitcnt vmcnt(0)" ::: "memory");
        } else {
            XB_SPIN(xb_ld(&bar[XB_XGEN(b.x)]) == gen, bar);
            __builtin_amdgcn_fence(__ATOMIC_ACQUIRE, "agent");
            asm volatile("s_waitcnt vmcnt(0)" ::: "memory");
        }
    }
    __syncthreads();
}

struct Frame {
    LAS unsigned char* lds;
    volatile LAS unsigned* MISC;
    unsigned* ctl;
    unsigned char* ws;
    int tid, lane, wave, G, vcu;
    const float* const* in;
    float* out;
};
__device__ __forceinline__ float wave_sum(float v) {
#pragma unroll
    for (int o = 1; o < 64; o <<= 1) v += __shfl_xor(v, o);
    return v;
}

#define LAUNDER_V(x) asm volatile("" : "+v"(x))
#define LAUNDER_S(x) asm volatile("" : "+s"(x))
__device__ __forceinline__ Frame phase_frame(const Frame& G) { Frame F = G; asm volatile("v_mbcnt_lo_u32_b32 %0, -1, 0\n\tv_mbcnt_hi_u32_b32 %0, -1, %0" : "=v"(F.lane)); F.tid = F.wave * 64 + F.lane; LAUNDER_S(F.ws); F.ctl = (unsigned*)(F.ws + WS_CTL); return F; }
using pg8::Unit; using pg8::cvt_pk_bf16;
#define EPI_LANE const int ln_ = pg8::lane_now(); fr = ln_ & 15; fq = ln_ >> 4
#define EPI_ROWS(u) EPI_LANE; const int row0 = (u).pm * 256 + wr * 64 + fr
#define EPI_RS8(ssq4) float rs8[8]; { f32x4 pp_[8]; _Pragma("unroll") for (int it_ = 0; it_ < 8; ++it_) pp_[it_] = *(const GAS f32x4*)((ssq4) + (size_t)(row0 + (it_ >> 2) * 128 + (it_ & 3) * 16) * 4); \
    _Pragma("unroll") for (int it_ = 0; it_ < 8; ++it_) rs8[it_] = __builtin_amdgcn_rsqf(((pp_[it_][0] + pp_[it_][1]) + (pp_[it_][2] + pp_[it_][3])) * (1.f / DM) + RMS_EPS); }
#define EPI_RS8_LDS() float rs8[8]; { const LAS f32x4* sp_ = (const LAS f32x4*)(EPI_SSQ_LDS); f32x4 pp_[8]; _Pragma("unroll") for (int it_ = 0; it_ < 8; ++it_) pp_[it_] = sp_[(it_ >> 2) * 128 + wr * 64 + (it_ & 3) * 16 + fr]; \
    _Pragma("unroll") for (int it_ = 0; it_ < 8; ++it_) rs8[it_] = __builtin_amdgcn_rsqf(((pp_[it_][0] + pp_[it_][1]) + (pp_[it_][2] + pp_[it_][3])) * (1.f / DM) + RMS_EPS); }
#define EPI_PREFETCH_SSQ(ssq4) static constexpr bool PRE = true; \
    __device__ __forceinline__ void prefetch(const Unit& u, int wid, LAS unsigned char*) const { if (wid < 4) __builtin_amdgcn_global_load_lds((const unsigned*)((ssq4) + ((size_t)u.pm * 256 + 64 * wid + pg8::lane_now()) * 4), (LAS unsigned*)(this->sl + 1024 * wid), 16, 0, 0); }
#define EPI_NO_PREFETCH static constexpr bool PRE = false; __device__ __forceinline__ void prefetch(const Unit&, int, LAS unsigned char*) const {}
#define EPI_FOR_AM _Pragma("unroll") for (int ai = 0; ai < 2; ++ai) _Pragma("unroll") for (int m = 0; m < 4; ++m, __builtin_amdgcn_sched_barrier(0))

__device__ __forceinline__ float row_rstd(const GAS float* ssq4, int row) { const f32x4 p = *(const GAS f32x4*)(ssq4 + (size_t)row * 4); return __builtin_amdgcn_rsqf(((p[0] + p[1]) + (p[2] + p[3])) * (1.f / DM) + RMS_EPS); }
struct EpiA {
    static constexpr bool MID = false;
    static constexpr bool PRE = true;
    __device__ __forceinline__ void prefetch(const Unit& u, int wid, LAS unsigned char*) const {
        if (wid < 4) __builtin_amdgcn_global_load_lds((const unsigned*)(ssq + ((size_t)u.pm * 256 + 64 * wid + pg8::lane_now()) * 4), (LAS unsigned*)(this->sl + 1024 * wid), 16, 0, 0);
        if (wid == 4) __builtin_amdgcn_global_load_lds((const unsigned*)(qkg + 4 * pg8::lane_now()), (LAS unsigned*)(this->sl + 4096), 16, 0, 0); }
    GAS bf16* O; const GAS float* ssq; const GAS float* qkg; LAS unsigned char* sl;
    __device__ __forceinline__ void operator()(const f32x4 (&acc)[2][2][4][2], const Unit& u, int wr, int wc, int fr, int fq) const {
        EPI_ROWS(u); EPI_RS8_LDS();
        if (u.pn < 6) {
            const int colb = u.pn * 256 + 64 * wc + 8 * fq;
            const LAS float* gs = (const LAS float*)(sl + 4096) + (u.pn < 3 ? 0 : 64);
            f32x4 gv[2][2];
#pragma unroll
            for (int bj = 0; bj < 2; ++bj)
#pragma unroll
                for (int n = 0; n < 2; ++n) gv[bj][n] = *(const LAS f32x4*)(gs + 32 * bj + 8 * fq + 4 * n);
            EPI_FOR_AM { const int row = row0 + ai * 128 + m * 16; const float rs = rs8[ai * 4 + m];
                float s = 0.f;
#pragma unroll
                for (int bj = 0; bj < 2; ++bj)
#pragma unroll
                    for (int n = 0; n < 2; ++n) { const f32x4 x = acc[ai][bj][m][n]; s += (x[0] * x[0] + x[1] * x[1]) + (x[2] * x[2] + x[3] * x[3]); }
                s += __shfl_xor(s, 16); s += __shfl_xor(s, 32);
                const float f = rs * __builtin_amdgcn_rsqf(rs * rs * s * (1.f / 64.f) + RMS_EPS);
#pragma unroll
                for (int bj = 0; bj < 2; ++bj) { const f32x4 v0 = acc[ai][bj][m][0] * f * gv[bj][0], v1 = acc[ai][bj][m][1] * f * gv[bj][1];
                    v4u w; w.x = cvt_pk_bf16(v0[0], v0[1]); w.y = cvt_pk_bf16(v0[2], v0[3]); w.z = cvt_pk_bf16(v1[0], v1[1]); w.w = cvt_pk_bf16(v1[2], v1[3]);
                    *(GAS v4u*)(O + (size_t)row * NAO + colb + 32 * bj) = w; } }
        } else if (u.pn >= 9 && u.pn < 15) {
            const int colb = 2304 + (u.pn - 9) * 128 + 32 * wc + 8 * fq;
            EPI_FOR_AM { const int row = row0 + ai * 128 + m * 16; const float r2 = rs8[ai * 4 + m] * rs8[ai * 4 + m];
                const f32x4 v0 = acc[ai][0][m][0] * acc[ai][1][m][0] * r2, v1 = acc[ai][0][m][1] * acc[ai][1][m][1] * r2;
                v4u w; w.x = cvt_pk_bf16(v0[0], v0[1]); w.y = cvt_pk_bf16(v0[2], v0[3]); w.z = cvt_pk_bf16(v1[0], v1[1]); w.w = cvt_pk_bf16(v1[2], v1[3]);
                *(GAS v4u*)(O + (size_t)row * NAO + colb) = w; }
        } else {
            const int colb = (u.pn < 9 ? u.pn * 256 : 3072 + (u.pn - 15) * 256) + 64 * wc + 8 * fq;
            EPI_FOR_AM { const int row = row0 + ai * 128 + m * 16; const float rs = rs8[ai * 4 + m];
#pragma unroll
                for (int bj = 0; bj < 2; ++bj) { const f32x4 v0 = acc[ai][bj][m][0] * rs, v1 = acc[ai][bj][m][1] * rs;
                    v4u w; w.x = cvt_pk_bf16(v0[0], v0[1]); w.y = cvt_pk_bf16(v0[2], v0[3]); w.z = cvt_pk_bf16(v1[0], v1[1]); w.w = cvt_pk_bf16(v1[2], v1[3]);
                    *(GAS v4u*)(O + (size_t)row * NAO + colb + 32 * bj) = w; } }
        }
    }
};
struct EpiC {
    static constexpr bool MID = false;
    EPI_PREFETCH_SSQ(ssq)
    GAS bf16* O; const GAS float* ssq; const GAS float* lbt; LAS unsigned char* sl;
    __device__ __forceinline__ void operator()(const f32x4 (&acc)[2][2][4][2], const Unit& u, int wr, int wc, int fr, int fq) const {
        EPI_ROWS(u); const int colb = u.pn * 256 + 64 * wc + 8 * fq; const int kind = u.pn / 3; EPI_RS8_LDS();
        if (kind == 1) {
            f32x4 lb[2][2], ob[2][2];
#pragma unroll
            for (int bj = 0; bj < 2; ++bj)
#pragma unroll
                for (int n = 0; n < 2; ++n) { lb[bj][n] = *(const GAS f32x4*)(lbt + (colb - 768 + 32 * bj + 4 * n)); ob[bj][n] = 1.f - lb[bj][n]; }
            EPI_FOR_AM { const int row = row0 + ai * 128 + m * 16; const float k1 = rs8[ai * 4 + m] * 1.4426950408889634f;
#pragma unroll
                for (int bj = 0; bj < 2; ++bj) { f32x4 v[2];
#pragma unroll
                    for (int n = 0; n < 2; ++n) { const f32x4 t = acc[ai][bj][m][n] * k1; f32x4 ez, d, r, sg;
#pragma unroll
                        for (int e = 0; e < 4; ++e) ez[e] = __builtin_amdgcn_exp2f(-__builtin_fabsf(t[e]));
                        d = ez + 1.f;
#pragma unroll
                        for (int e = 0; e < 4; ++e) r[e] = __builtin_amdgcn_rcpf(d[e]);
#pragma unroll
                        for (int e = 0; e < 4; ++e) sg[e] = (t[e] >= 0.f) ? r[e] : ez[e] * r[e];
                        f32x4 wv = ob[bj][n] * sg + lb[bj][n];
#pragma unroll
                        for (int e = 0; e < 4; ++e) wv[e] = __builtin_amdgcn_logf(__builtin_fmaxf(wv[e], 1e-37f));
                        v[n] = wv; }
                    v4u w; w.x = cvt_pk_bf16(v[0][0], v[0][1]); w.y = cvt_pk_bf16(v[0][2], v[0][3]); w.z = cvt_pk_bf16(v[1][0], v[1][1]); w.w = cvt_pk_bf16(v[1][2], v[1][3]);
                    *(GAS v4u*)(O + (size_t)row * NC + colb + 32 * bj) = w; } }
        } else if (kind == 2) {
            EPI_FOR_AM { const int row = row0 + ai * 128 + m * 16; const float rs = rs8[ai * 4 + m];
#pragma unroll
                for (int bj = 0; bj < 2; ++bj) { const f32x4 v0 = acc[ai][bj][m][0] * rs, v1 = acc[ai][bj][m][1] * rs;
                    v4u w; w.x = cvt_pk_bf16(v0[0], v0[1]); w.y = cvt_pk_bf16(v0[2], v0[3]); w.z = cvt_pk_bf16(v1[0], v1[1]); w.w = cvt_pk_bf16(v1[2], v1[3]);
                    *(GAS v4u*)(O + (size_t)row * NC + colb + 32 * bj) = w; } }
        } else {
            EPI_FOR_AM { const int row = row0 + ai * 128 + m * 16; const float rs = rs8[ai * 4 + m]; const float k1 = rs * -1.4426950408889634f;
#pragma unroll
                for (int bj = 0; bj < 2; ++bj) { f32x4 v[2];
#pragma unroll
                    for (int n = 0; n < 2; ++n) { const f32x4 a = acc[ai][bj][m][n]; const f32x4 t = a * k1; f32x4 d, r;
#pragma unroll
                        for (int e = 0; e < 4; ++e) d[e] = __builtin_amdgcn_exp2f(t[e]);
                        d += 1.f;
#pragma unroll
                        for (int e = 0; e < 4; ++e) r[e] = __builtin_amdgcn_rcpf(d[e]);
                        v[n] = (a * rs) * r; }
                    v4u w; w.x = cvt_pk_bf16(v[0][0], v[0][1]); w.y = cvt_pk_bf16(v[0][2], v[0][3]); w.z = cvt_pk_bf16(v[1][0], v[1][1]); w.w = cvt_pk_bf16(v[1][2], v[1][3]);
                    *(GAS v4u*)(O + (size_t)row * NC + colb + 32 * bj) = w; } }
        }
    }
};
__device__ __forceinline__ float ub0(unsigned x) { return (float)(x & 0xffu); }
__device__ __forceinline__ float ub1(unsigned x) { return (float)((x >> 8) & 0xffu); }
__device__ __forceinline__ float ub2(unsigned x) { return (float)((x >> 16) & 0xffu); }
__device__ __forceinline__ float ub3(unsigned x) { return (float)(x >> 24); }
struct EpiG {
    static constexpr bool MID = false;
    EPI_PREFETCH_SSQ(ssq)
    GAS unsigned char* O; const GAS float* ssq; LAS unsigned char* sl;
    __device__ __forceinline__ void operator()(const f32x4 (&acc)[2][2][4][2], const Unit& u, int wr, int wc, int fr, int fq) const {
        EPI_ROWS(u); const int colb = u.pn * 256 + 64 * wc + 8 * fq; EPI_RS8_LDS();
        EPI_FOR_AM { const int row = row0 + ai * 128 + m * 16; const float k1 = rs8[ai * 4 + m] * -1.4426950408889634f;
#pragma unroll
            for (int bj = 0; bj < 2; ++bj) { v2u w; w.x = 0u; w.y = 0u;
#pragma unroll
                for (int n = 0; n < 2; ++n) { const f32x4 t = acc[ai][bj][m][n] * k1; f32x4 d, r;
#pragma unroll
                    for (int e = 0; e < 4; ++e) d[e] = __builtin_amdgcn_exp2f(t[e]);
                    d += 1.f;
#pragma unroll
                    for (int e = 0; e < 4; ++e) r[e] = __builtin_amdgcn_rcpf(d[e]);
                    const f32x4 q = r * 254.f + 1.5f; unsigned pk = 0u;
                    pk = __builtin_amdgcn_cvt_pk_u8_f32(q[0], 0, pk); pk = __builtin_amdgcn_cvt_pk_u8_f32(q[1], 1, pk); pk = __builtin_amdgcn_cvt_pk_u8_f32(q[2], 2, pk); pk = __builtin_amdgcn_cvt_pk_u8_f32(q[3], 3, pk);
                    if (n == 0) w.x = pk; else w.y = pk; }
                *(GAS v2u*)(O + (size_t)row * NG + colb + 32 * bj) = w; } }
    }
};
struct EpiM {
    static constexpr bool MID = true;
    EPI_NO_PREFETCH
    GAS bf16* O; const GAS unsigned char* Gt;
    __device__ __forceinline__ bool is_mid(int t) const { return t == 4 || t == 16; }
    __device__ __forceinline__ void mid(f32x4 (&acc)[2][2][4][2], const Unit& u, int t, int wr, int wc, int fr, int fq) const {
        EPI_ROWS(u); const int colb = u.pn * 256 + 64 * wc + 8 * fq; const int sel = (t == 4) ? 0 : 1024;
        const GAS unsigned char* gp0 = Gt + (size_t)row0 * NG + sel + colb;
        v2u ga[2][4][2], gb[2][4][2];
#pragma unroll
        for (int ai = 0; ai < 2; ++ai)
#pragma unroll
            for (int m = 0; m < 4; ++m)
#pragma unroll
                for (int bj = 0; bj < 2; ++bj) { const GAS unsigned char* gp = gp0 + (size_t)(ai * 128 + m * 16) * NG + 32 * bj; ga[ai][m][bj] = *(const GAS v2u*)gp; gb[ai][m][bj] = *(const GAS v2u*)(gp + 1024); }
#pragma unroll
        for (int ai = 0; ai < 2; ++ai) {
#pragma unroll
            for (int m = 0; m < 4; ++m)
#pragma unroll
                for (int bj = 0; bj < 2; ++bj) { const v2u a = ga[ai][m][bj], b = gb[ai][m][bj]; f32x4 r0, r1;
                    r0[0] = ub0(a.x) * fast_rcp(ub0(b.x)); r0[1] = ub1(a.x) * fast_rcp(ub1(b.x)); r0[2] = ub2(a.x) * fast_rcp(ub2(b.x)); r0[3] = ub3(a.x) * fast_rcp(ub3(b.x));
                    r1[0] = ub0(a.y) * fast_rcp(ub0(b.y)); r1[1] = ub1(a.y) * fast_rcp(ub1(b.y)); r1[2] = ub2(a.y) * fast_rcp(ub2(b.y)); r1[3] = ub3(a.y) * fast_rcp(ub3(b.y));
                    acc[ai][bj][m][0] *= r0; acc[ai][bj][m][1] *= r1; }
            __builtin_amdgcn_sched_barrier(0); }
    }
    __device__ __forceinline__ void operator()(const f32x4 (&acc)[2][2][4][2], const Unit& u, int wr, int wc, int fr, int fq) const {
        EPI_ROWS(u); const int colb = u.pn * 256 + 64 * wc + 8 * fq;
        v2u cg[8][2];
#pragma unroll
        for (int it = 0; it < 8; ++it)
#pragma unroll
            for (int bj = 0; bj < 2; ++bj) cg[it][bj] = *(const GAS v2u*)(Gt + (size_t)(row0 + (it >> 2) * 128 + (it & 3) * 16) * NG + 2048 + colb + 32 * bj);
        EPI_FOR_AM { const int row = row0 + ai * 128 + m * 16;
#pragma unroll
            for (int bj = 0; bj < 2; ++bj) { const v2u c = cg[ai * 4 + m][bj]; constexpr float k = 1.f / 255.f;
                const f32x4 v0 = acc[ai][bj][m][0] * ((f32x4){ub0(c.x), ub1(c.x), ub2(c.x), ub3(c.x)} * k), v1 = acc[ai][bj][m][1] * ((f32x4){ub0(c.y), ub1(c.y), ub2(c.y), ub3(c.y)} * k);
                v4u w; w.x = cvt_pk_bf16(v0[0], v0[1]); w.y = cvt_pk_bf16(v0[2], v0[3]); w.z = cvt_pk_bf16(v1[0], v1[1]); w.w = cvt_pk_bf16(v1[2], v1[3]);
                *(GAS v4u*)(O + (size_t)row * DM + colb + 32 * bj) = w; } }
    }
};
struct EpiO {
    static constexpr bool MID = false;
    EPI_NO_PREFETCH
    GAS bf16* x16; GAS float* ssq4; LAS float* xch;
    __device__ __forceinline__ void operator()(const f32x4 (&acc)[2][2][4][2], const Unit& u, int wr, int wc, int fr, int fq) const {
        EPI_ROWS(u); const int colb = u.pn * 256 + 64 * wc + 8 * fq;
        v4u cb[2][4][2];
#pragma unroll
        for (int ai = 0; ai < 2; ++ai)
#pragma unroll
            for (int m = 0; m < 4; ++m)
#pragma unroll
                for (int bj = 0; bj < 2; ++bj) cb[ai][m][bj] = *(const GAS v4u*)(x16 + (size_t)(row0 + ai * 128 + m * 16) * DM + colb + 32 * bj);
#pragma unroll
        for (int ai = 0; ai < 2; ++ai) {
#pragma unroll
            for (int m = 0; m < 4; ++m) { const int row = row0 + ai * 128 + m * 16; f32x4 s4 = {0.f, 0.f, 0.f, 0.f};
#pragma unroll
                for (int bj = 0; bj < 2; ++bj) { const size_t off = (size_t)row * DM + colb + 32 * bj; const v4u c = cb[ai][m][bj];
                    const f32x4 v0 = (f32x4){bflo(c.x), bfhi(c.x), bflo(c.y), bfhi(c.y)} + acc[ai][bj][m][0], v1 = (f32x4){bflo(c.z), bfhi(c.z), bflo(c.w), bfhi(c.w)} + acc[ai][bj][m][1];
                    s4 += v0 * v0; s4 += v1 * v1;
                    v4u w; w.x = cvt_pk_bf16(v0[0], v0[1]); w.y = cvt_pk_bf16(v0[2], v0[3]); w.z = cvt_pk_bf16(v1[0], v1[1]); w.w = cvt_pk_bf16(v1[2], v1[3]);
                    *(GAS v4u*)(x16 + off) = w; }
                float s = (s4[0] + s4[1]) + (s4[2] + s4[3]);
                s += __shfl_xor(s, 16); s += __shfl_xor(s, 32);
                if (fq == 0) xch[(ai * 128 + wr * 64 + m * 16 + fr) * 4 + wc] = s; }
            __builtin_amdgcn_sched_barrier(0); }
        asm volatile("s_waitcnt lgkmcnt(0)" ::: "memory"); __builtin_amdgcn_s_barrier(); asm volatile("" ::: "memory");
        if (wr == 0) { const int r = wc * 64 + ln_; const f32x4 p = *(const LAS f32x4*)(xch + r * 4); ssq4[(size_t)(u.pm * 256 + r) * 4 + u.pn] = (p[0] + p[1]) + (p[2] + p[3]); }
    }
};
struct EpiU {
    static constexpr bool MID = false;
    EPI_PREFETCH_SSQ(ssq)
    GAS bf16* H; const GAS float* ssq; LAS unsigned char* sl;
    __device__ __forceinline__ void operator()(const f32x4 (&acc)[2][2][4][2], const Unit& u, int wr, int wc, int fr, int fq) const {
        EPI_ROWS(u); const int colb = u.pn * 128 + 32 * wc + 8 * fq; EPI_RS8_LDS();
        EPI_FOR_AM { const int row = row0 + ai * 128 + m * 16; const float rs = rs8[ai * 4 + m]; const float k1 = rs * -1.4426950408889634f, k2 = rs * rs;
            f32x4 h[2];
#pragma unroll
            for (int n = 0; n < 2; ++n) { const f32x4 a1 = acc[ai][0][m][n], a3 = acc[ai][1][m][n]; const f32x4 t = a1 * k1; f32x4 d, r;
#pragma unroll
                for (int e = 0; e < 4; ++e) d[e] = __builtin_amdgcn_exp2f(t[e]);
                d += 1.f;
#pragma unroll
                for (int e = 0; e < 4; ++e) r[e] = __builtin_amdgcn_rcpf(d[e]);
                h[n] = ((a1 * k2) * a3) * r; }
            v4u w; w.x = cvt_pk_bf16(h[0][0], h[0][1]); w.y = cvt_pk_bf16(h[0][2], h[0][3]); w.z = cvt_pk_bf16(h[1][0], h[1][1]); w.w = cvt_pk_bf16(h[1][2], h[1][3]);
            *(GAS v4u*)(H + (size_t)row * FFD + colb) = w; }
    }
};

struct MoeOrder {
    const char* A; const char* Bt; size_t bstride; const int* idx; volatile LAS int* tb; int nN, nwg, G, c, lim, ubase;
    __device__ __forceinline__ void decode(int w, Unit& u) const {
        int g = 0, base = 0;
#pragma unroll
        for (int j = 1; j < 16; ++j) { const int b = tb[j] * nN; if (w >= b) { g = j; base = b; } }
        const int ntile = tb[g + 1] - tb[g]; pg8::tile_decode(w - base, ntile, nN, u.pm, u.pn); u.g = g;
    }
    __device__ __forceinline__ bool next(int i, Unit& u) const { const long L = (long)i * G + c; if (L >= lim) return false; decode(pg8::xcd_remap((int)L, nwg) + ubase, u); return true; }
};
struct MoeUpOrder : MoeOrder {
    static constexpr bool GATHER = true;
    __device__ __forceinline__ const char* abase(const Unit&, size_t) const { return A; }
    __device__ __forceinline__ const char* bbase(const Unit& u, size_t tstep) const { return Bt + (size_t)(u.g & 7) * bstride + (size_t)u.pn * tstep; }
    __device__ __forceinline__ void idx_prefetch(const Unit& u, int wid, LAS int* dst) const {
        if (wid == 0) __builtin_amdgcn_global_load_lds((const unsigned*)(idx + (size_t)u.g * M + u.pm * 256 + 4 * pg8::lane_now()), (LAS unsigned*)dst, 16, 0, 0); }
    __device__ __forceinline__ void avoff_lds(const Unit& u, int wid, int pitchb, unsigned (&vA)[2][2], const LAS int* ix) const {
        const int cnt = tb[32 + u.g]; const int tid = wid * 64 + pg8::lane_now();
#pragma unroll
        for (int i = 0; i < 2; ++i) { int R, C; pg8::stage_rc(tid * 16 + i * 8192, R, C);
#pragma unroll
            for (int h = 0; h < 2; ++h) { const int p = u.pm * 256 + 128 * h + R; const int t_ = ix[128 * h + R]; const int tok = (p < cnt) ? t_ : 0; vA[h][i] = (unsigned)(tok * pitchb + C * 2); } }
    }
    __device__ __forceinline__ void avoff(const Unit& u, int wid, int pitchb, unsigned (&vA)[2][2]) const {
        const int cnt = tb[32 + u.g]; const int* ix = idx + (size_t)u.g * M + u.pm * 256; const int tid = wid * 64 + pg8::lane_now();
#pragma unroll
        for (int i = 0; i < 2; ++i) { int R, C; pg8::stage_rc(tid * 16 + i * 8192, R, C);
#pragma unroll
            for (int h = 0; h < 2; ++h) { const int p = u.pm * 256 + 128 * h + R; const int tok = (p < cnt) ? ix[128 * h + R] : 0; vA[h][i] = (unsigned)(tok * pitchb + C * 2); } }
    }
};
struct MoeDownOrder : MoeOrder {
    static constexpr bool GATHER = false;
    __device__ __forceinline__ const char* abase(const Unit& u, size_t tstep) const { return A + (size_t)(tb[u.g] + u.pm) * tstep; }
    __device__ __forceinline__ const char* bbase(const Unit& u, size_t tstep) const { return Bt + (size_t)(u.g & 7) * bstride + (size_t)u.pn * tstep; }
    __device__ __forceinline__ void avoff(const Unit&, int, int, unsigned (&)[2][2]) const {}
    __device__ __forceinline__ void avoff_lds(const Unit&, int, int, unsigned (&)[2][2], const PG8_LAS int*) const {}
    __device__ __forceinline__ void idx_prefetch(const Unit&, int, PG8_LAS int*) const {}
};
struct EpiMU {
    static constexpr bool MID = false;
    EPI_NO_PREFETCH
    GAS unsigned char* H; volatile LAS int* tb;
    __device__ __forceinline__ void operator()(const f32x4 (&acc)[2][2][4][2], const Unit& u, int wr, int wc, int fr, int fq) const {
        EPI_LANE; const int colb = u.pn * 128 + 32 * wc + 8 * fq; const int hrow0 = (tb[u.g] + u.pm) * 256;
        GAS unsigned char* hp = H + (size_t)(hrow0 + wr * 64 + fr) * FFE + colb;
        constexpr float K1 = -1.4426950408889634f / SW1, K2 = SH / (SW1 * SW1);
        EPI_FOR_AM { v2u w;
#pragma unroll
            for (int n = 0; n < 2; ++n) { const f32x4 a1 = acc[ai][0][m][n], a3 = acc[ai][1][m][n]; const f32x4 t = a1 * K1; f32x4 d;
#pragma unroll
                for (int e = 0; e < 4; ++e) d[e] = __builtin_amdgcn_exp2f(t[e]);
                d += 1.f; f32x4 r;
#pragma unroll
                for (int e = 0; e < 4; ++e) r[e] = __builtin_amdgcn_rcpf(d[e]);
                const f32x4 h = ((a1 * K2) * a3) * r;
                const unsigned pk = pk4_fp8(h[0], h[1], h[2], h[3]); if (n == 0) w.x = pk; else w.y = pk; }
            *(GAS v2u*)(hp + (size_t)(ai * 128 + m * 16) * FFE) = w; }
    }
};
struct EpiMD {
    static constexpr bool MID = false;
    static constexpr bool PRE = true;
    GAS bf16* x16; GAS float* out; const GAS int* idx; const GAS float* gate; volatile LAS int* tb; LAS unsigned char* sl;
    __device__ __forceinline__ void prefetch(const Unit& u, int wid, LAS unsigned char*) const {
        const size_t li = (size_t)u.g * M + u.pm * 256 + 4 * pg8::lane_now();
        if (wid == 4) __builtin_amdgcn_global_load_lds((const unsigned*)(idx + li), (LAS unsigned*)sl, 16, 0, 0);
        if (wid == 5) __builtin_amdgcn_global_load_lds((const unsigned*)(gate + li), (LAS unsigned*)(sl + 1024), 16, 0, 0); }
    __device__ __forceinline__ void operator()(const f32x4 (&acc)[2][2][4][2], const Unit& u, int wr, int wc, int fr, int fq) const {
        EPI_LANE; const int colb = u.pn * 256 + 64 * wc + 8 * fq; const int cnt = tb[32 + u.g];
        int tok8[8]; float gt8[8];
#pragma unroll
        for (int it = 0; it < 8; ++it) { const int r_ = (it >> 2) * 128 + wr * 64 + (it & 3) * 16 + fr; const bool ok = u.pm * 256 + r_ < cnt; const int t_ = ((const LAS int*)sl)[r_]; const float g_ = ((const LAS float*)(sl + 1024))[r_]; tok8[it] = ok ? t_ : -1; gt8[it] = ok ? g_ * (1.f / (SH * SW2)) : 0.f; }
        v4u cb[2][4][2];
#pragma unroll
        for (int it = 0; it < 8; ++it) { const int tk = tok8[it]; const GAS bf16* xp = x16 + (size_t)(tk < 0 ? 0 : tk) * DM + colb;
#pragma unroll
            for (int bj = 0; bj < 2; ++bj) cb[it >> 2][it & 3][bj] = *(const GAS v4u*)(xp + 32 * bj); }
#pragma unroll
        for (int ai = 0; ai < 2; ++ai) {
#pragma unroll
            for (int m = 0; m < 4; ++m) { const int tk = tok8[ai * 4 + m];
                if (tk >= 0) { const float gt = gt8[ai * 4 + m]; const size_t off = (size_t)tk * DM + colb;
#pragma unroll
                    for (int bj = 0; bj < 2; ++bj) { const v4u c = cb[ai][m][bj];
                        const f32x4 v0 = (f32x4){bflo(c.x), bfhi(c.x), bflo(c.y), bfhi(c.y)} + acc[ai][bj][m][0] * gt, v1 = (f32x4){bflo(c.z), bfhi(c.z), bflo(c.w), bfhi(c.w)} + acc[ai][bj][m][1] * gt;
                        if (out) { *(GAS f32x4*)(out + off + 32 * bj) = v0; *(GAS f32x4*)(out + off + 32 * bj + 4) = v1; }
                        else { v4u w; w.x = cvt_pk_bf16(v0[0], v0[1]); w.y = cvt_pk_bf16(v0[2], v0[3]); w.z = cvt_pk_bf16(v1[0], v1[1]); w.w = cvt_pk_bf16(v1[2], v1[3]); *(GAS v4u*)(x16 + off + 32 * bj) = w; } } } }
            __builtin_amdgcn_sched_barrier(0); }
    }
};

__device__ __forceinline__ void conv_item(const float* src, int sN, int scol0, int k0, const float* gain, bf16* dst, int dpitch, int drow0, int dk0, LAS float* scr, int lane) {
    const int rg = lane >> 3, c4 = (lane & 7) * 4; f32x4 v[8];
#pragma unroll
    for (int i = 0; i < 8; ++i) v[i] = __builtin_nontemporal_load((const f32x4*)(src + (size_t)(k0 + 8 * i + rg) * sN + scol0 + c4));
    if (gain) {
#pragma unroll
        for (int i = 0; i < 8; ++i) v[i] *= gain[k0 + 8 * i + rg]; }
#pragma unroll
    for (int i = 0; i < 8; ++i) { LAS float* d = scr + (8 * i + rg) * 33 + c4; d[0] = v[i][0]; d[1] = v[i][1]; d[2] = v[i][2]; d[3] = v[i][3]; }
    LDS_WAIT(); asm volatile("" ::: "memory");
    const int c = lane & 7;
#pragma unroll
    for (int j = 0; j < 4; ++j) { const int o = (lane >> 3) + 8 * j; const int rho = 16 * ((o >> 2) & 1) + 4 * (o >> 3) + (o & 3); const LAS float* s = scr + (8 * c) * 33 + o;
        v4u w; w.x = pk2(s[0 * 33], s[1 * 33]); w.y = pk2(s[2 * 33], s[3 * 33]); w.z = pk2(s[4 * 33], s[5 * 33]); w.w = pk2(s[6 * 33], s[7 * 33]);
        *(v4u*)(dst + (size_t)(drow0 + rho) * dpitch + dk0 + k0 + 8 * c) = w; }
    LDS_WAIT(); asm volatile("" ::: "memory");
}
__device__ __forceinline__ void conv_std(const float* W, int sN, int scol_off, int ncols, const float* gain, bf16* dst, int dpitch, int dk0, int item, LAS float* scr, int lane) {
    const int ng = ncols / 32, kb = item / ng, gi = item % ng; const int tile = gi >> 3, bj = (gi & 7) >> 2, wc = gi & 3;
    conv_item(W, sN, scol_off + 256 * tile + 64 * wc + 32 * bj, 64 * kb, gain, dst, dpitch, 32 * gi, dk0, scr, lane);
}
__device__ __forceinline__ void conv_up(const float* w1, const float* w3, int ff, const float* gain, bf16* dst, int item, LAS float* scr, int lane) {
    const int ng = 2 * ff / 32, kb = item / ng, gi = item % ng; const int pn = gi >> 3, bj = (gi & 7) >> 2, wc = gi & 3;
    conv_item(bj ? w3 : w1, ff, 128 * pn + 32 * wc, 64 * kb, gain, dst, DM, 32 * gi, 0, scr, lane);
}

__device__ __forceinline__ void conv_item8(const float* src, int sN, int scol0, int k0, const float* gain, float scale, unsigned char* dst, int dpitch, int drow0, LAS float* scr, int lane) {
    const int rg = lane >> 3, c4 = (lane & 7) * 4; f32x4 v[8];
#pragma unroll
    for (int i = 0; i < 8; ++i) v[i] = __builtin_nontemporal_load((const f32x4*)(src + (size_t)(k0 + 8 * i + rg) * sN + scol0 + c4));
#pragma unroll
    for (int i = 0; i < 8; ++i) v[i] *= gain ? gain[k0 + 8 * i + rg] * scale : scale;
#pragma unroll
    for (int i = 0; i < 8; ++i) { LAS float* d = scr + (8 * i + rg) * 33 + c4; d[0] = v[i][0]; d[1] = v[i][1]; d[2] = v[i][2]; d[3] = v[i][3]; }
    LDS_WAIT(); asm volatile("" ::: "memory");
    const int c = lane & 3;
#pragma unroll
    for (int j = 0; j < 2; ++j) { const int o = (lane >> 2) + 16 * j; const int rho = 16 * ((o >> 2) & 1) + 4 * (o >> 3) + (o & 3); const LAS float* s = scr + (16 * c) * 33 + o;
        v4u w; w.x = pk4_fp8(s[0 * 33], s[1 * 33], s[2 * 33], s[3 * 33]); w.y = pk4_fp8(s[4 * 33], s[5 * 33], s[6 * 33], s[7 * 33]); w.z = pk4_fp8(s[8 * 33], s[9 * 33], s[10 * 33], s[11 * 33]); w.w = pk4_fp8(s[12 * 33], s[13 * 33], s[14 * 33], s[15 * 33]);
        *(v4u*)(dst + (size_t)(drow0 + rho) * dpitch + k0 + 16 * c) = w; }
    LDS_WAIT(); asm volatile("" ::: "memory");
}
__device__ __forceinline__ void conv_std8(const float* W, int sN, int ncols, float scale, unsigned char* dst, int dpitch, int item, LAS float* scr, int lane) {
    const int ng = ncols / 32, kb = item / ng, gi = item % ng; const int tile = gi >> 3, bj = (gi & 7) >> 2, wc = gi & 3;
    conv_item8(W, sN, 256 * tile + 64 * wc + 32 * bj, 64 * kb, nullptr, scale, dst, dpitch, 32 * gi, scr, lane);
}
__device__ __forceinline__ void conv_up8(const float* w1, const float* w3, int ff, const float* gain, float scale, unsigned char* dst, int item, LAS float* scr, int lane) {
    const int ng = 2 * ff / 32, kb = item / ng, gi = item % ng; const int pn = gi >> 3, bj = (gi & 7) >> 2, wc = gi & 3;
    conv_item8(bj ? w3 : w1, ff, 128 * pn + 32 * wc, 64 * kb, gain, scale, dst, DM, 32 * gi, scr, lane);
}

__device__ __forceinline__ void p_prologue(const Frame& F_) {
    Frame F = phase_frame(F_);
    LAS float* scr = (LAS float*)(F.lds + RING_OFF + F.wave * 16384);
    const int gw = F.vcu * NWAVES + F.wave, NGW = F.G * NWAVES;
    constexpr int I_A = 16 * (NA / 32), I_C = 16 * (NC / 32), I_G = 16 * (NG / 32), I_PA = 4 * 32, I_PB = 12 * 32, I_PC = 12 * 32, I_O = 16 * 32;
    constexpr int I_L = I_A + I_C + I_G + I_PA + I_PB + I_PC + I_O;
    constexpr int I_13 = 16 * (2 * FFD / 32), I_2 = (FFD / 64) * 32;
    constexpr int NITEMS = 2 * I_L + I_13 + I_2;
    for (int it = gw; it < NITEMS; it += NGW) {
        int r = it;
        if (r < 2 * I_L) { const int l = r / I_L; r -= l * I_L;
            bf16* wl = (bf16*)(F.ws + WS_W + l * SZ_WL); const float* win = F.in[3] + (size_t)l * DM * INCOLS; const float* gn = F.in[1] + l * DM;
            if (r < I_A) { const int ng = NA / 32, kb = r / ng, gi = r % ng; bf16* wa = (bf16*)((char*)wl + OFF_WA);
                if (gi < 72) conv_std(win, INCOLS, 0, 2304, gn, wa, DM, 0, kb * 72 + gi, scr, F.lane);
                else if (gi < 120) { const int pg = gi - 72, pn = pg >> 3, bj = (pg & 7) >> 2, wc = pg & 3;
                    conv_item(win, INCOLS, (bj ? 3840 : 2304) + 128 * pn + 32 * wc, 64 * kb, gn, wa, DM, 32 * gi, 0, scr, F.lane); }
                else { const int tg = gi - 120, tile = tg >> 3, bj = (tg & 7) >> 2, wc = tg & 3;
                    conv_item(win, INCOLS, 3072 + 256 * tile + 64 * wc + 32 * bj, 64 * kb, gn, wa, DM, 32 * gi, 0, scr, F.lane); }
                continue; } r -= I_A;
            if (r < I_C) { conv_std(win, INCOLS, NA, NC, gn, (bf16*)((char*)wl + OFF_WC), DM, 0, r, scr, F.lane); continue; } r -= I_C;
            if (r < I_G) { conv_std(win, INCOLS, NA + NC, NG, gn, (bf16*)((char*)wl + OFF_WG), DM, 0, r, scr, F.lane); continue; } r -= I_G;
            bf16* wp = (bf16*)((char*)wl + OFF_WP);
            if (r < I_PA) { conv_std(F.in[9] + (size_t)l * 256 * DM, DM, 0, DM, nullptr, wp, KP, 0, r, scr, F.lane); continue; } r -= I_PA;
            if (r < I_PB) { conv_std(F.in[10] + (size_t)l * 768 * DM, DM, 0, DM, nullptr, wp, KP, 256, r, scr, F.lane); continue; } r -= I_PB;
            if (r < I_PC) { conv_std(F.in[11] + (size_t)l * 768 * DM, DM, 0, DM, nullptr, wp, KP, 1024, r, scr, F.lane); continue; } r -= I_PC;
            conv_std(F.in[12] + (size_t)l * DM * DM, DM, 0, DM, nullptr, (bf16*)((char*)wl + OFF_WO), DM, 0, r, scr, F.lane); continue;
        }
        r -= 2 * I_L;
        if (r < I_13) { conv_up(F.in[13], F.in[14], FFD, F.in[2], (bf16*)(F.ws + WS_W13), r, scr, F.lane); continue; } r -= I_13;
        conv_std(F.in[15], DM, 0, DM, nullptr, (bf16*)(F.ws + WS_W2), FFD, 0, r, scr, F.lane);
    }
    float* ssq0 = (float*)(F.ws + WS_SSQ); bf16* x16 = (bf16*)(F.ws + WS_X16);
    for (int m = gw; m < M; m += NGW) {
        const f32x4* xr = (const f32x4*)(F.in[0] + (size_t)m * DM) + F.lane; f32x4 v[4]; float s = 0.f;
#pragma unroll
        for (int j = 0; j < 4; ++j) { v[j] = __builtin_nontemporal_load(xr + 64 * j); s += (v[j].x * v[j].x + v[j].y * v[j].y) + (v[j].z * v[j].z + v[j].w * v[j].w); }
        s = wave_sum(s);
        v2u* o8 = (v2u*)(x16 + (size_t)m * DM) + F.lane;
#pragma unroll
        for (int j = 0; j < 4; ++j) { v2u w; w.x = pk2(v[j].x, v[j].y); w.y = pk2(v[j].z, v[j].w); o8[64 * j] = w; }
        if (F.lane == 0) *(f32x4*)(ssq0 + (size_t)m * 4) = (f32x4){s, 0.f, 0.f, 0.f};
    }
    float* misc = (float*)(F.ws + WS_MISC);
    const int gt = F.vcu * NTHR + F.tid, NGT = F.G * NTHR;
    for (int i = gt; i < DM * NEXP; i += NGT) misc[MI_RGW + i] = F.in[2][DM + (i >> 3)] * F.in[16][i];
    for (int i = gt; i < 2 * 768; i += NGT) { const int l = i / 768, c = i % 768; float lb = 0.f;
        if (l == 1) { const float p0 = F.in[7][c], p1 = F.in[7][768 + c]; lb = 1.f / (1.f + expf(p0 - p1)); }
        misc[MI_LBA + i] = lb; }
    for (int i = gt; i < 2 * 256; i += NGT) { const int l = i >> 8, c = i & 255; misc[MI_QKG + i] = (c < 64) ? F.in[4][l * 64 + c] * QSCALE : (c < 128) ? F.in[5][l * 64 + c - 64] : 0.f; }
}

typedef short bf16x8_t __attribute__((ext_vector_type(8)));
typedef float f32x16 __attribute__((ext_vector_type(16)));
typedef short v4i16_t __attribute__((ext_vector_type(4)));
constexpr int AT_VSTR = 144, AT_WAVE_LDS = 32 * AT_VSTR + 128;
constexpr int AT_ASTR = 144, AT_ACC = NWAVES * AT_WAVE_LDS, AT_LACC = AT_ACC + 512 * AT_ASTR;
static_assert(AT_LACC + 512 * 4 <= RING_BYTES, "attention lds");
__device__ __forceinline__ void p_attn_mfma(const Frame& F_) {
    Frame F = phase_frame(F_);
    const bf16* QKV = (const bf16*)(F.ws + R_BUFA); bf16* MIX = (bf16*)(F.ws + R_MIX);
    const int lane = F.lane, r32 = lane & 31, hi = lane >> 5;
    LAS unsigned char* wl = F.lds + F.wave * AT_WAVE_LDS;
    LAS unsigned char* vt = wl; LAS float* linv = (LAS float*)(wl + 32 * AT_VSTR);
    LAS unsigned char* accb = F.lds + AT_ACC; LAS float* lacc = (LAS float*)(F.lds + AT_LACC);
    const int li = lane & 15; const int vtr_off = ((li >> 2) + 4 * hi) * AT_VSTR + (16 * ((lane >> 4) & 1) + 4 * (li & 3)) * 2;
    for (int item = F.vcu; item < BATCH * 8 * 4; item += F.G) {
        const int hg = item & 3, bs = (item >> 2) & 7, b = item >> 5;
#pragma unroll 1
        for (int g = 0; g < 3; ++g) {
            const int d = 1 << (2 * g), head = 4 * g + hg;
#pragma unroll 1
            for (int rep = 0; rep < 2; ++rep) {
                const int k = F.wave + 8 * rep, rho = k & (d - 1), chunk = k >> (2 * g);
                const int qpos0 = ((512 * bs) >> (2 * g)) + 32 * chunk;
                const int base = qpos0 - 128;
                const int lt0 = rho + d * 32 * chunk;
                const size_t tok0 = (size_t)b * SEQ + rho;
                f32x16 o0, o1; float l = 0.f;
                if (g == 0) {
#pragma unroll
                    for (int i = 0; i < 16; ++i) { o0[i] = 0.f; o1[i] = 0.f; }
                } else {
#pragma unroll
                    for (int i = 0; i < 16; ++i) { const int q = (i & 3) + 8 * (i >> 2) + 4 * hi; const LAS unsigned short* ap = (const LAS unsigned short*)(accb + (lt0 + d * q) * AT_ASTR) + r32;
                        o0[i] = __uint_as_float((unsigned)ap[0] << 16); o1[i] = __uint_as_float((unsigned)ap[32] << 16); }
                }
                bf16x8_t qf[4];
                { const bf16* qp = QKV + (tok0 + (size_t)d * (qpos0 + r32)) * NAO + head * 64 + 8 * hi;
#pragma unroll
                  for (int d0 = 0; d0 < 4; ++d0) qf[d0] = *(const bf16x8_t*)(qp + 16 * d0); }
                const bf16* kbase = QKV + tok0 * NAO + 768 + head * 64 + 8 * hi;
                const bf16* vbase = QKV + tok0 * NAO + 1536 + head * 64 + (lane & 7) * 8;
                constexpr int ntile = (128 + 31) / 32 + 1;
                int t0 = 0; if (base < -31) t0 = (-base) >> 5;
                bf16x8_t kf[4]; v4u vf[4];
                { const int kidx = base + 32 * t0 + r32; const bf16* kp = kbase + (size_t)d * (kidx < 0 ? 0 : kidx) * NAO;
#pragma unroll
                  for (int d0 = 0; d0 < 4; ++d0) kf[d0] = *(const bf16x8_t*)(kp + 16 * d0);
#pragma unroll
                  for (int i = 0; i < 4; ++i) { const int vi = base + 32 * t0 + (lane >> 3) + 8 * i; vf[i] = *(const v4u*)(vbase + (size_t)d * (vi < 0 ? 0 : vi) * NAO); } }
                const int c0 = 128 + r32 - 4 * hi;
#pragma unroll 1
                for (int t = t0; t < ntile; ++t) {
#pragma unroll
                    for (int i = 0; i < 4; ++i) *(LAS v4u*)(vt + ((lane >> 3) + 8 * i) * AT_VSTR + (lane & 7) * 16) = vf[i];
                    bf16x8_t kc[4];
#pragma unroll
                    for (int d0 = 0; d0 < 4; ++d0) kc[d0] = kf[d0];
                    if (t + 1 < ntile) { const int kidx = base + 32 * (t + 1) + r32; const bf16* kp = kbase + (size_t)d * (kidx < 0 ? 0 : kidx) * NAO;
#pragma unroll
                        for (int d0 = 0; d0 < 4; ++d0) kf[d0] = *(const bf16x8_t*)(kp + 16 * d0);
#pragma unroll
                        for (int i = 0; i < 4; ++i) { const int vi = base + 32 * (t + 1) + (lane >> 3) + 8 * i; vf[i] = *(const v4u*)(vbase + (size_t)d * (vi < 0 ? 0 : vi) * NAO); } }
                    f32x16 p;
#pragma unroll
                    for (int i = 0; i < 16; ++i) p[i] = 0.f;
#pragma unroll
                    for (int d0 = 0; d0 < 4; ++d0) p = __builtin_amdgcn_mfma_f32_32x32x16_bf16(kc[d0], qf[d0], p, 0, 0, 0);
                    const int cr = c0 - 32 * t, ck = base + 32 * t + 4 * hi;
                    if (t >= 1 && t <= 3 && base + 32 * t >= 0) {
#pragma unroll
                        for (int i = 0; i < 16; ++i) { p[i] = __builtin_amdgcn_exp2f(p[i]); l += p[i]; }
                    } else {
#pragma unroll
                        for (int i = 0; i < 16; ++i) { const int kk = (i & 3) + 8 * (i >> 2); const bool ok = ((unsigned)(cr - kk) <= 128u) && (ck + kk >= 0);
                            const float e = __builtin_amdgcn_exp2f(p[i]); p[i] = ok ? e : 0.f; l += p[i]; }
                    }
                    bf16x8_t pa0, pa1;
                    { v4u w0, w1; w0.x = cvt_pk_bf16(p[0], p[1]); w0.y = cvt_pk_bf16(p[2], p[3]); w0.z = cvt_pk_bf16(p[4], p[5]); w0.w = cvt_pk_bf16(p[6], p[7]);
                      w1.x = cvt_pk_bf16(p[8], p[9]); w1.y = cvt_pk_bf16(p[10], p[11]); w1.z = cvt_pk_bf16(p[12], p[13]); w1.w = cvt_pk_bf16(p[14], p[15]);
                      pa0 = __builtin_bit_cast(bf16x8_t, w0); pa1 = __builtin_bit_cast(bf16x8_t, w1); }
#pragma unroll
                    for (int db = 0; db < 2; ++db) {
                        bf16x8_t vb[2];
#pragma unroll
                        for (int ss = 0; ss < 2; ++ss) {
                            const v4i16_t lo = __builtin_amdgcn_ds_read_tr16_b64_v4i16((LAS v4i16_t*)(vt + vtr_off + (16 * ss) * AT_VSTR + db * 64));
                            const v4i16_t hh = __builtin_amdgcn_ds_read_tr16_b64_v4i16((LAS v4i16_t*)(vt + vtr_off + (16 * ss + 8) * AT_VSTR + db * 64));
                            vb[ss] = (bf16x8_t){lo[0], lo[1], lo[2], lo[3], hh[0], hh[1], hh[2], hh[3]}; }
                        if (db == 0) { o0 = __builtin_amdgcn_mfma_f32_32x32x16_bf16(pa0, vb[0], o0, 0, 0, 0); o0 = __builtin_amdgcn_mfma_f32_32x32x16_bf16(pa1, vb[1], o0, 0, 0, 0); }
                        else         { o1 = __builtin_amdgcn_mfma_f32_32x32x16_bf16(pa0, vb[0], o1, 0, 0, 0); o1 = __builtin_amdgcn_mfma_f32_32x32x16_bf16(pa1, vb[1], o1, 0, 0, 0); }
                    }
                }
                l += __shfl_xor(l, 32);
                if (g < 2) {
                    if (hi == 0) lacc[lt0 + d * r32] = (g == 0) ? l : l + lacc[lt0 + d * r32];
#pragma unroll
                    for (int i = 0; i < 16; ++i) { const int q = (i & 3) + 8 * (i >> 2) + 4 * hi; LAS unsigned short* ap = (LAS unsigned short*)(accb + (lt0 + d * q) * AT_ASTR) + r32;
                        ap[0] = (unsigned short)f2bf(o0[i]); ap[32] = (unsigned short)f2bf(o1[i]); }
                } else {
                    if (hi == 0) linv[r32] = 1.f / (l + lacc[lt0 + d * r32]);
#pragma unroll
                    for (int i = 0; i < 16; ++i) { const int q = (i & 3) + 8 * (i >> 2) + 4 * hi; const float il = linv[q]; LAS unsigned short* ap = (LAS unsigned short*)(accb + (lt0 + d * q) * AT_ASTR) + r32;
                        ap[0] = (unsigned short)f2bf(o0[i] * il); ap[32] = (unsigned short)f2bf(o1[i] * il); }
#pragma unroll
                    for (int i = 0; i < 4; ++i) { const int q = (lane >> 3) + 8 * i; const v4u w = *(const LAS v4u*)(accb + (lt0 + d * q) * AT_ASTR + (lane & 7) * 16);
                        *(v4u*)(MIX + ((size_t)b * SEQ + 512 * bs + lt0 + d * q) * KP + hg * 64 + (lane & 7) * 8) = w; }
                }
            }
            __syncthreads();
        }
    }
}
__device__ __forceinline__ void p_conv(const Frame& F_, int l) {
    Frame F = phase_frame(F_);
    const bf16* P = (const bf16*)(F.ws + R_BUFA); bf16* MIX = (bf16*)(F.ws + R_MIX); const float* cw = F.in[6] + l * 3 * 768;
    if (F.tid < 384) {
        const int tl = F.tid / 96, c8 = (F.tid % 96) * 8;
        f32x4 w[3][2];
#pragma unroll
        for (int j = 0; j < 3; ++j) { w[j][0] = *(const f32x4*)(cw + 768 * j + c8); w[j][1] = *(const f32x4*)(cw + 768 * j + c8 + 4); }
        for (int blk = F.vcu; blk < M / 128; blk += F.G) {
            const int t0 = blk * 128 + tl * 32, s0 = t0 & (SEQ - 1);
            v4u hw1 = {0u, 0u, 0u, 0u}, hw2 = {0u, 0u, 0u, 0u};
            if (s0 >= 1) hw1 = *(const v4u*)(P + (size_t)(t0 - 1) * NAO + 2304 + c8);
            if (s0 >= 2) hw2 = *(const v4u*)(P + (size_t)(t0 - 2) * NAO + 2304 + c8);
            f32x4 h1[2] = {(f32x4){bflo(hw1.x), bfhi(hw1.x), bflo(hw1.y), bfhi(hw1.y)}, (f32x4){bflo(hw1.z), bfhi(hw1.z), bflo(hw1.w), bfhi(hw1.w)}};
            f32x4 h2[2] = {(f32x4){bflo(hw2.x), bfhi(hw2.x), bflo(hw2.y), bfhi(hw2.y)}, (f32x4){bflo(hw2.z), bfhi(hw2.z), bflo(hw2.w), bfhi(hw2.w)}};
#pragma unroll 1
            for (int i0 = 0; i0 < 32; i0 += 8) {
                v4u uu[8], bb[8];
#pragma unroll
                for (int i = 0; i < 8; ++i) { const bf16* rp = P + (size_t)(t0 + i0 + i) * NAO + c8; uu[i] = *(const v4u*)(rp + 2304); bb[i] = *(const v4u*)(rp + 3072); }
#pragma unroll
                for (int i = 0; i < 8; ++i) {
                    const f32x4 u0[2] = {(f32x4){bflo(uu[i].x), bfhi(uu[i].x), bflo(uu[i].y), bfhi(uu[i].y)}, (f32x4){bflo(uu[i].z), bfhi(uu[i].z), bflo(uu[i].w), bfhi(uu[i].w)}};
                    const f32x4 g[2] = {(f32x4){bflo(bb[i].x), bfhi(bb[i].x), bflo(bb[i].y), bfhi(bb[i].y)}, (f32x4){bflo(bb[i].z), bfhi(bb[i].z), bflo(bb[i].w), bfhi(bb[i].w)}};
                    f32x4 y[2];
#pragma unroll
                    for (int n = 0; n < 2; ++n) { y[n] = g[n] * (w[0][n] * u0[n] + w[1][n] * h1[n] + w[2][n] * h2[n]); h2[n] = h1[n]; h1[n] = u0[n]; }
                    v4u o; o.x = cvt_pk_bf16(y[0][0], y[0][1]); o.y = cvt_pk_bf16(y[0][2], y[0][3]); o.z = cvt_pk_bf16(y[1][0], y[1][1]); o.w = cvt_pk_bf16(y[1][2], y[1][3]);
                    *(v4u*)(MIX + (size_t)(t0 + i0 + i) * KP + 256 + c8) = o; }
            }
        }
    }
}
typedef float f32x4v __attribute__((ext_vector_type(4)));
constexpr int HS = 272;
constexpr int H1_BSTR = 544;
__device__ __forceinline__ int h1_ci(int c) { return ((((c >> 2) ^ ((c >> 6) & 1)) << 2) + (c & 3)); }
constexpr int H1_LF = 0, H1_BF = 17408, H1_QT = 52224, H1_KT = H1_QT + 64 * HS, H1_VT = H1_KT + 64 * HS, H1_PS = H1_VT + 64 * HS, H1_BSEG = H1_PS + 2048, H1_EREF = H1_BSEG + 512, H1_LAM = H1_EREF + 512, H1_EK = H1_LAM + 512, H1_REF = H1_EK + 512, H1_VT2 = H1_REF + 512;
static_assert(H1_VT2 + 64 * HS <= RING_BYTES && H1_BF + 64 * H1_BSTR <= H1_QT, "hgrn lds");
__device__ __forceinline__ bf16x8_t trpair(LAS unsigned char* p0, LAS unsigned char* p1) {
    const v4i16_t a = __builtin_amdgcn_ds_read_tr16_b64_v4i16((LAS v4i16_t*)p0), b = __builtin_amdgcn_ds_read_tr16_b64_v4i16((LAS v4i16_t*)p1);
    return (bf16x8_t){a[0], a[1], a[2], a[3], b[0], b[1], b[2], b[3]};
}
__device__ __forceinline__ bf16x8_t pack8(const f32x4v a, const f32x4v b) { v4u w; w.x = cvt_pk_bf16(a[0], a[1]); w.y = cvt_pk_bf16(a[2], a[3]); w.z = cvt_pk_bf16(b[0], b[1]); w.w = cvt_pk_bf16(b[2], b[3]); return __builtin_bit_cast(bf16x8_t, w); }
__device__ __forceinline__ void unpack8(const v4u w, float (&x)[8]) { x[0] = bflo(w.x); x[1] = bfhi(w.x); x[2] = bflo(w.y); x[3] = bfhi(w.y); x[4] = bflo(w.z); x[5] = bfhi(w.z); x[6] = bflo(w.w); x[7] = bfhi(w.w); }
__device__ __forceinline__ void p_hgrn1_mfma(const Frame& F_) {
    Frame F = phase_frame(F_);
    const bf16* HGB = (const bf16*)(F.ws + R_HG); bf16* OL = (bf16*)(F.ws + R_OLOC); bf16* QD = (bf16*)(F.ws + R_QD); float* FST = (float*)(F.ws + R_FST); float* DST = (float*)(F.ws + R_DST);
    LAS unsigned char* L = F.lds;
    const int tid = F.tid, lane = F.lane, w = F.wave, c16 = lane & 15, g = lane >> 4;
    const int st = tid >> 3, sk = (tid & 7) * 16;
    const int ck = tid & 127, cq = tid >> 7;
    v4u rq[2], rf[2], rv[2];
#define H1_ROWS(tok_, h_) do { const bf16* rp = HGB + (size_t)((tok_) + st) * NC + (h_) * 128 + sk; \
        rq[0] = *(const v4u*)rp; rq[1] = *(const v4u*)(rp + 8); rf[0] = *(const v4u*)(rp + 768); rf[1] = *(const v4u*)(rp + 776); rv[0] = *(const v4u*)(rp + 1536); rv[1] = *(const v4u*)(rp + 1544); } while (0)
    if (F.vcu < BATCH * HG_H * HSEG) { const int bh = F.vcu / HSEG, j = F.vcu % HSEG; H1_ROWS((bh / HG_H) * SEQ + j * HSEGLEN, bh % HG_H); }
    for (int item = F.vcu; item < BATCH * HG_H * HSEG; item += F.G) {
        const int bh = item / HSEG, j = item % HSEG, b = bh / HG_H, h = bh % HG_H; const int tok0 = b * SEQ + j * HSEGLEN;
        f32x4v S[8];
#pragma unroll
        for (int i = 0; i < 8; ++i) S[i] = (f32x4v){0.f, 0.f, 0.f, 0.f};
        if (tid < 128) *(LAS float*)(L + H1_BSEG + 4 * tid) = 0.f;
#pragma unroll 1
        for (int ch = 0; ch < HSEGLEN / 64; ++ch) {
            const int ctok = tok0 + ch * 64;
            *(LAS v4u*)(L + H1_LF + st * HS + sk * 2) = rf[0]; *(LAS v4u*)(L + H1_LF + st * HS + sk * 2 + 16) = rf[1];
            const int vto = (ch & 1) ? H1_VT2 : H1_VT;
            *(LAS v4u*)(L + vto + st * HS + sk * 2) = rv[0]; *(LAS v4u*)(L + vto + st * HS + sk * 2 + 16) = rv[1];
            __syncthreads();
            { LAS unsigned char* lb = L + H1_LF + (4 * g + (c16 >> 2)) * HS + (16 * w + 4 * (c16 & 3)) * 2;
              bf16x8_t lfT[2];
#pragma unroll
              for (int p = 0; p < 2; ++p) lfT[p] = trpair(lb + (32 * p) * HS, lb + (32 * p + 16) * HS);
              const unsigned one = 0x3F803F80u;
              const unsigned tri01 = ((4 * g + 0 <= c16) ? 0x3F80u : 0u) | ((4 * g + 1 <= c16) ? 0x3F800000u : 0u), tri23 = ((4 * g + 2 <= c16) ? 0x3F80u : 0u) | ((4 * g + 3 <= c16) ? 0x3F800000u : 0u);
              v4u ma, mb, m1; ma.x = tri01; ma.y = tri23; ma.z = 0u; ma.w = 0u; mb.x = one; mb.y = one; mb.z = tri01; mb.w = tri23; m1.x = one; m1.y = one; m1.z = one; m1.w = one;
              const bf16x8_t Ma = __builtin_bit_cast(bf16x8_t, ma), Mb = __builtin_bit_cast(bf16x8_t, mb), M1 = __builtin_bit_cast(bf16x8_t, m1);
              const f32x4v z4 = (f32x4v){0.f, 0.f, 0.f, 0.f};
              f32x4v bt[4];
              bt[0] = __builtin_amdgcn_mfma_f32_16x16x32_bf16(lfT[0], Ma, z4, 0, 0, 0);
              bt[1] = __builtin_amdgcn_mfma_f32_16x16x32_bf16(lfT[0], Mb, z4, 0, 0, 0);
              bt[2] = __builtin_amdgcn_mfma_f32_16x16x32_bf16(lfT[0], M1, z4, 0, 0, 0); bt[2] = __builtin_amdgcn_mfma_f32_16x16x32_bf16(lfT[1], Ma, bt[2], 0, 0, 0);
              bt[3] = __builtin_amdgcn_mfma_f32_16x16x32_bf16(lfT[0], M1, z4, 0, 0, 0); bt[3] = __builtin_amdgcn_mfma_f32_16x16x32_bf16(lfT[1], Mb, bt[3], 0, 0, 0);
              f32x4v ref;
#pragma unroll
              for (int e = 0; e < 4; ++e) ref[e] = __shfl(bt[1][e], (lane & 48) | 15);
#pragma unroll
              for (int tt = 0; tt < 4; ++tt) *(LAS f32x4v*)(L + H1_BF + (16 * tt + c16) * H1_BSTR + h1_ci(16 * w + 4 * g) * 4) = bt[tt] - ref;
              if (c16 == 15) {
#pragma unroll
                  for (int e = 0; e < 4; ++e) { const int k = 16 * w + 4 * g + e; *(LAS float*)(L + H1_REF + k * 4) = ref[e]; *(LAS float*)(L + H1_EK + h1_ci(k) * 4) = __builtin_amdgcn_exp2f(*(const LAS float*)(L + H1_BSEG + 4 * k) + ref[e]); } }
            }
            __syncthreads();
            { float q[16], lf[16]; unpack8(rq[0], (float(&)[8])q[0]); unpack8(rq[1], (float(&)[8])q[8]); unpack8(rf[0], (float(&)[8])lf[0]); unpack8(rf[1], (float(&)[8])lf[8]);
              float qt[16], kt[16], qd[16];
#pragma unroll
              for (int c4 = 0; c4 < 4; ++c4) { const int ci = h1_ci(sk + 4 * c4) * 4; const f32x4v Bt = *(const LAS f32x4v*)(L + H1_BF + st * H1_BSTR + ci), Ek = *(const LAS f32x4v*)(L + H1_EK + ci);
#pragma unroll
                  for (int e = 0; e < 4; ++e) { const int i = 4 * c4 + e; const float d1 = Bt[e];
                      const float e1 = __builtin_amdgcn_exp2f(d1); qt[i] = q[i] * e1; kt[i] = (1.f - __builtin_amdgcn_exp2f(lf[i])) * fast_rcp(e1); qd[i] = qt[i] * Ek[e]; } }
              v4u wq0, wq1, wk0, wk1, wd0, wd1;
              wq0.x = cvt_pk_bf16(qt[0], qt[1]); wq0.y = cvt_pk_bf16(qt[2], qt[3]); wq0.z = cvt_pk_bf16(qt[4], qt[5]); wq0.w = cvt_pk_bf16(qt[6], qt[7]); wq1.x = cvt_pk_bf16(qt[8], qt[9]); wq1.y = cvt_pk_bf16(qt[10], qt[11]); wq1.z = cvt_pk_bf16(qt[12], qt[13]); wq1.w = cvt_pk_bf16(qt[14], qt[15]);
              wk0.x = cvt_pk_bf16(kt[0], kt[1]); wk0.y = cvt_pk_bf16(kt[2], kt[3]); wk0.z = cvt_pk_bf16(kt[4], kt[5]); wk0.w = cvt_pk_bf16(kt[6], kt[7]); wk1.x = cvt_pk_bf16(kt[8], kt[9]); wk1.y = cvt_pk_bf16(kt[10], kt[11]); wk1.z = cvt_pk_bf16(kt[12], kt[13]); wk1.w = cvt_pk_bf16(kt[14], kt[15]);
              wd0.x = cvt_pk_bf16(qd[0], qd[1]); wd0.y = cvt_pk_bf16(qd[2], qd[3]); wd0.z = cvt_pk_bf16(qd[4], qd[5]); wd0.w = cvt_pk_bf16(qd[6], qd[7]); wd1.x = cvt_pk_bf16(qd[8], qd[9]); wd1.y = cvt_pk_bf16(qd[10], qd[11]); wd1.z = cvt_pk_bf16(qd[12], qd[13]); wd1.w = cvt_pk_bf16(qd[14], qd[15]);
              *(LAS v4u*)(L + H1_QT + st * HS + sk * 2) = wq0; *(LAS v4u*)(L + H1_QT + st * HS + sk * 2 + 16) = wq1;
              *(LAS v4u*)(L + H1_KT + st * HS + sk * 2) = wk0; *(LAS v4u*)(L + H1_KT + st * HS + sk * 2 + 16) = wk1;
              bf16* dp = QD + (size_t)(ctok + st) * 768 + h * 128 + sk; *(v4u*)dp = wd0; *(v4u*)(dp + 8) = wd1; }
            if (tid < 128) { const float b31 = *(const LAS float*)(L + H1_REF + tid * 4), r63 = *(const LAS float*)(L + H1_BF + 63 * H1_BSTR + h1_ci(tid) * 4);
                *(LAS float*)(L + H1_EREF + tid * 4) = __builtin_amdgcn_exp2f(b31); *(LAS float*)(L + H1_LAM + tid * 4) = __builtin_amdgcn_exp2f(r63); }
            if (ch + 1 < HSEGLEN / 64) { H1_ROWS(ctok + 64, h); }
            else if (item + F.G < BATCH * HG_H * HSEG) { const int nb = (item + F.G) / HSEG, nj = (item + F.G) % HSEG; H1_ROWS((nb / HG_H) * SEQ + nj * HSEGLEN, nb % HG_H); }
            __syncthreads();
            if (tid < 128) *(LAS float*)(L + H1_BSEG + 4 * tid) += *(const LAS float*)(L + H1_BF + 63 * H1_BSTR + h1_ci(tid) * 4) + *(const LAS float*)(L + H1_REF + tid * 4);
            bf16x8_t sa[4];
#pragma unroll
            for (int kt8 = 0; kt8 < 8; ++kt8) S[kt8] *= *(const LAS f32x4v*)(L + H1_EREF + (16 * kt8 + 4 * g) * 4);
#pragma unroll
            for (int kb = 0; kb < 4; ++kb) sa[kb] = pack8(S[2 * kb], S[2 * kb + 1]);
            bf16x8_t vtf[2];
            { LAS unsigned char* vb = L + vto + (4 * g + (c16 >> 2)) * HS + (16 * w + 4 * (c16 & 3)) * 2;
#pragma unroll
              for (int p = 0; p < 2; ++p) vtf[p] = trpair(vb + (32 * p) * HS, vb + (32 * p + 16) * HS); }
            { LAS unsigned char* atl = L + H1_BF;
#pragma unroll
              for (int rep = 0; rep < 2; ++rep) { const int ti = w + 8 * rep;
                if (ti < 10) { const int tt = (ti >= 6) ? 3 : (ti >= 3) ? 2 : (ti >= 1) ? 1 : 0, a = ti - (tt * (tt + 1)) / 2;
                    f32x4v at = (f32x4v){0.f, 0.f, 0.f, 0.f};
#pragma unroll
                    for (int ks = 0; ks < 4; ++ks) { const bf16x8_t qn = *(const LAS bf16x8_t*)(L + H1_QT + (16 * tt + c16) * HS + (32 * ks + 8 * g) * 2);
                        const bf16x8_t kf = *(const LAS bf16x8_t*)(L + H1_KT + (16 * a + c16) * HS + (32 * ks + 8 * g) * 2);
                        at = __builtin_amdgcn_mfma_f32_16x16x32_bf16(kf, qn, at, 0, 0, 0); }
                    if (a == tt) {
#pragma unroll
                        for (int e = 0; e < 4; ++e) at[e] = (4 * g + e <= c16) ? at[e] : 0.f; }
                    v2u hv; hv.x = cvt_pk_bf16(at[0], at[1]); hv.y = cvt_pk_bf16(at[2], at[3]);
                    *(LAS v2u*)(atl + ((tt * 4 + a) * 64 + lane) * 8) = hv; } } }
            f32x4v o[4];
#pragma unroll
            for (int tt = 0; tt < 4; ++tt) { o[tt] = (f32x4v){0.f, 0.f, 0.f, 0.f};
#pragma unroll
                for (int kb = 0; kb < 4; ++kb) {
                    const LAS unsigned char* qp = L + H1_QT + (16 * tt + c16) * HS + (32 * kb + 4 * g) * 2;
                    const v2u lo = *(const LAS v2u*)qp, hh = *(const LAS v2u*)(qp + 32); v4u qq; qq.x = lo.x; qq.y = lo.y; qq.z = hh.x; qq.w = hh.y;
                    o[tt] = __builtin_amdgcn_mfma_f32_16x16x32_bf16(sa[kb], __builtin_bit_cast(bf16x8_t, qq), o[tt], 0, 0, 0); } }
            { bf16x8_t vf[2];
              LAS unsigned char* vb = L + vto + (8 * g + (c16 >> 2)) * HS + (16 * w + 4 * (c16 & 3)) * 2;
#pragma unroll
              for (int p = 0; p < 2; ++p) vf[p] = trpair(vb + (32 * p) * HS, vb + (32 * p + 4) * HS);
#pragma unroll
              for (int kt8 = 0; kt8 < 8; ++kt8) {
                  LAS unsigned char* kb_ = L + H1_KT + (8 * g + (c16 >> 2)) * HS + (16 * kt8 + 4 * (c16 & 3)) * 2;
#pragma unroll
                  for (int p = 0; p < 2; ++p) S[kt8] = __builtin_amdgcn_mfma_f32_16x16x32_bf16(trpair(kb_ + (32 * p) * HS, kb_ + (32 * p + 4) * HS), vf[p], S[kt8], 0, 0, 0);
                  S[kt8] *= *(const LAS f32x4v*)(L + H1_LAM + (16 * kt8 + 4 * g) * 4); } }
            __syncthreads();
#pragma unroll
            for (int tt = 0; tt < 4; ++tt) {
                const LAS unsigned char* atl = L + H1_BF + (tt * 4 * 64 + lane) * 8;
                { const v2u h0 = *(const LAS v2u*)atl; v2u h1 = {0u, 0u}; if (tt >= 1) h1 = *(const LAS v2u*)(atl + 512);
                  v4u f; f.x = h0.x; f.y = h0.y; f.z = h1.x; f.w = h1.y;
                  o[tt] = __builtin_amdgcn_mfma_f32_16x16x32_bf16(vtf[0], __builtin_bit_cast(bf16x8_t, f), o[tt], 0, 0, 0); }
                if (tt >= 2) { const v2u h2 = *(const LAS v2u*)(atl + 1024); v2u h3 = {0u, 0u}; if (tt == 3) h3 = *(const LAS v2u*)(atl + 1536);
                  v4u f; f.x = h2.x; f.y = h2.y; f.z = h3.x; f.w = h3.y;
                  o[tt] = __builtin_amdgcn_mfma_f32_16x16x32_bf16(vtf[1], __builtin_bit_cast(bf16x8_t, f), o[tt], 0, 0, 0); }
                { v2u ow; ow.x = cvt_pk_bf16(o[tt][0], o[tt][1]); ow.y = cvt_pk_bf16(o[tt][2], o[tt][3]); *(v2u*)(OL + (size_t)(ctok + 16 * tt + c16) * 768 + h * 128 + 16 * w + 4 * g) = ow; }
            }
        }
        { bf16* fp = (bf16*)FST + (size_t)item * 16384 + (size_t)(16 * w + c16) * 128 + 4 * g;
#pragma unroll
          for (int kt8 = 0; kt8 < 8; ++kt8) { v2u ow; ow.x = cvt_pk_bf16(S[kt8][0], S[kt8][1]); ow.y = cvt_pk_bf16(S[kt8][2], S[kt8][3]); *(v2u*)(fp + 16 * kt8) = ow; } }
        if (tid < 128) DST[item * 128 + tid] = __builtin_amdgcn_exp2f(*(const LAS float*)(L + H1_BSEG + 4 * tid));
        __syncthreads();
    }
}
constexpr int H2_TT = 0, H2_OG = 2 * 128 * HS, H2_DT = H2_OG + 512;
__device__ __forceinline__ void p_hgrn2_mfma(const Frame& F_, int l) {
    Frame F = phase_frame(F_);
    const bf16* HGB = (const bf16*)(F.ws + R_HG); const bf16* OL = (const bf16*)(F.ws + R_OLOC); const bf16* QD = (const bf16*)(F.ws + R_QD); const float* FST = (const float*)(F.ws + R_FST); const float* DST = (const float*)(F.ws + R_DST);
    bf16* MIX = (bf16*)(F.ws + R_MIX); const float* og = F.in[8] + l * 128;
    LAS unsigned char* L = F.lds;
    const int tid = F.tid, lane = F.lane, w = F.wave, c16 = lane & 15, g = lane >> 4;
    const int cv = tid >> 2, ckq = (tid & 3) * 32;
    for (int wi = F.vcu; wi < BATCH * HG_H * 5; wi += F.G) {
        const int bh = wi / 5, part = wi % 5, b = bh / HG_H, h = bh % HG_H; const int j0 = (part == 0) ? 0 : 3 * part + 1, j1 = 3 * part + 4;
        f32x4v T[8];
#pragma unroll
        for (int i = 0; i < 8; ++i) T[i] = (f32x4v){0.f, 0.f, 0.f, 0.f};
        __syncthreads();
#pragma unroll
        for (int i = 0; i < 4; ++i) *(LAS float*)(L + H2_DT + 4 * (tid + 512 * i)) = DST[bh * HSEG * 128 + tid + 512 * i];
        __syncthreads();
        for (int i0 = 0; i0 < j0; i0 += 4) {
            v4u fw[4][4];
#pragma unroll
            for (int u = 0; u < 4; ++u) { const int i = (i0 + u < j0) ? i0 + u : j0 - 1; const bf16* fp = (const bf16*)FST + (size_t)(bh * HSEG + i) * 16384 + cv * 128 + ckq;
#pragma unroll
                for (int e = 0; e < 4; ++e) fw[u][e] = *(const v4u*)(fp + 8 * e); }
#pragma unroll
            for (int u = 0; u < 4; ++u) { if (i0 + u < j0) { const LAS float* dp = (const LAS float*)(L + H2_DT) + (i0 + u) * 128 + ckq;
#pragma unroll
                for (int e = 0; e < 4; ++e) { const v4u f = fw[u][e];
                    T[2 * e] = *(const LAS f32x4v*)(dp + 8 * e) * T[2 * e] + (f32x4v){bflo(f.x), bfhi(f.x), bflo(f.y), bfhi(f.y)}; T[2 * e + 1] = *(const LAS f32x4v*)(dp + 8 * e + 4) * T[2 * e + 1] + (f32x4v){bflo(f.z), bfhi(f.z), bflo(f.w), bfhi(f.w)}; } } }
        }
        if (tid < 128) *(LAS float*)(L + H2_OG + 4 * tid) = og[tid];
#define H2_LOAD(ol_, qf_, gg_, jj_, t2_) do { const int tk_ = b * SEQ + (jj_) * HSEGLEN + 16 * (2 * w + (t2_)) + c16; \
            _Pragma("unroll") for (int vt = 0; vt < 8; ++vt) ol_[vt] = *(const v2u*)(OL + (size_t)tk_ * 768 + h * 128 + 16 * vt + 4 * g); \
            _Pragma("unroll") for (int ks = 0; ks < 4; ++ks) qf_[ks] = *(const bf16x8_t*)(QD + (size_t)tk_ * 768 + h * 128 + 32 * ks + 8 * g); \
            _Pragma("unroll") for (int vt = 0; vt < 8; ++vt) gg_[vt] = *(const v2u*)(HGB + (size_t)tk_ * NC + 2304 + h * 128 + 16 * vt + 4 * g); } while (0)
#define H2_TILE(ol_, qf_, gg_, jj_, t2_) do { const int tok = b * SEQ + (jj_) * HSEGLEN + 16 * (2 * w + (t2_)) + c16; f32x4v o[8]; \
            _Pragma("unroll") for (int vt = 0; vt < 8; ++vt) { const v2u x = ol_[vt]; o[vt] = (f32x4v){bflo(x.x), bfhi(x.x), bflo(x.y), bfhi(x.y)}; } \
            if ((jj_) > 0) { _Pragma("unroll") for (int vt = 0; vt < 8; ++vt) _Pragma("unroll") for (int ks = 0; ks < 4; ++ks) { \
                const bf16x8_t tf = *(const LAS bf16x8_t*)(L + tto + (16 * vt + c16) * HS + (32 * ks + 8 * g) * 2);       \
                o[vt] = __builtin_amdgcn_mfma_f32_16x16x32_bf16(tf, qf_[ks], o[vt], 0, 0, 0); } } \
            float ss = 0.f; \
            _Pragma("unroll") for (int vt = 0; vt < 8; ++vt) ss += (o[vt][0] * o[vt][0] + o[vt][1] * o[vt][1]) + (o[vt][2] * o[vt][2] + o[vt][3] * o[vt][3]); \
            ss += __shfl_xor(ss, 16); ss += __shfl_xor(ss, 32); \
            const float r = __builtin_amdgcn_rsqf(ss * (1.f / 128.f) + RMS_EPS); \
            _Pragma("unroll") for (int vt = 0; vt < 8; ++vt) { const int vv = 16 * vt + 4 * g; const f32x4v gn = *(const LAS f32x4v*)(L + H2_OG + 4 * vv); const v2u gx = gg_[vt]; \
                v2u ow; ow.x = cvt_pk_bf16(o[vt][0] * r * gn[0] * bflo(gx.x), o[vt][1] * r * gn[1] * bfhi(gx.x)); ow.y = cvt_pk_bf16(o[vt][2] * r * gn[2] * bflo(gx.y), o[vt][3] * r * gn[3] * bfhi(gx.y)); \
                *(v2u*)(MIX + (size_t)tok * KP + 1024 + h * 128 + vv) = ow; } } while (0)
        v2u olA[8], ggA[8], olB[8], ggB[8]; bf16x8_t qfA[4], qfB[4];
        H2_LOAD(olA, qfA, ggA, j0, 0);
#pragma unroll 1
        for (int j = j0; j < j1; ++j) {
            const int tto = H2_TT + (j & 1) * 128 * HS;
            v4u fw[4];
            { const int jf = (j + 1 < j1) ? j : j0; const bf16* fp = (const bf16*)FST + (size_t)(bh * HSEG + jf) * 16384 + cv * 128 + ckq;
#pragma unroll
              for (int e = 0; e < 4; ++e) fw[e] = *(const v4u*)(fp + 8 * e); }
            H2_LOAD(olB, qfB, ggB, j, 1);
            if (j > 0) {
#pragma unroll
                for (int e = 0; e < 4; ++e) *(LAS bf16x8_t*)(L + tto + cv * HS + (ckq + 8 * e) * 2) = pack8(T[2 * e], T[2 * e + 1]); }
            if (j + 1 < j1) { const LAS float* dp = (const LAS float*)(L + H2_DT) + j * 128 + ckq;
#pragma unroll
                for (int e = 0; e < 4; ++e) { const v4u f = fw[e];
                    T[2 * e] = *(const LAS f32x4v*)(dp + 8 * e) * T[2 * e] + (f32x4v){bflo(f.x), bfhi(f.x), bflo(f.y), bfhi(f.y)}; T[2 * e + 1] = *(const LAS f32x4v*)(dp + 8 * e + 4) * T[2 * e + 1] + (f32x4v){bflo(f.z), bfhi(f.z), bflo(f.w), bfhi(f.w)}; } }
            __syncthreads();
            H2_TILE(olA, qfA, ggA, j, 0);
            { const int jn = (j + 1 < j1) ? j + 1 : j; H2_LOAD(olA, qfA, ggA, jn, 0); }
            H2_TILE(olB, qfB, ggB, j, 1);
        }
        __syncthreads();
#undef H2_LOAD
#undef H2_TILE
    }
}
__device__ __forceinline__ void p_route(const Frame& F_) {
    Frame F = phase_frame(F_);
    LAS float* gwt = (LAS float*)(F.lds + 65536);
    const float* misc = (const float*)(F.ws + WS_MISC);
    for (int i = F.tid; i < DM * NEXP; i += NTHR) { const int k = i >> 3, e = i & 7, slot = (8 * (k >> 9) + (k & 7)) * 64 + ((k >> 3) & 63); gwt[(e >> 2) * 4096 + slot * 4 + (e & 3)] = misc[MI_RGW + i]; }
    LAS unsigned* lcnt = (LAS unsigned*)(F.lds + 98304); LAS unsigned* lbase = lcnt + 16; LAS int* rrow = (LAS int*)(F.lds + 98304 + 256);
    if (F.tid < 16) lcnt[F.tid] = 0u;
    __syncthreads();
    const int gw = F.vcu * NWAVES + F.wave, NGW = F.G * NWAVES;
    int* lidx = (int*)(F.ws + R_LIST); float* lgate = (float*)(F.ws + R_LIST) + 16 * M;
    unsigned* cnt = F.ctl + CW_CNT;
    int nrow = 0;
    v4u xn[2];
    if (gw < M) { const v4u* xr = (const v4u*)((const bf16*)(F.ws + WS_X16) + (size_t)gw * DM) + F.lane; xn[0] = xr[0]; xn[1] = xr[64]; }
    for (int m = gw; m < M; m += NGW) {
        float lg[8]; float s = 0.f; v4u xk[2]; xk[0] = xn[0]; xk[1] = xn[1];
        { const int mn = (m + NGW < M) ? m + NGW : m; const v4u* xr = (const v4u*)((const bf16*)(F.ws + WS_X16) + (size_t)mn * DM) + F.lane; xn[0] = xr[0]; xn[1] = xr[64]; }
#pragma unroll
        for (int e = 0; e < 8; ++e) lg[e] = 0.f;
#pragma unroll
        for (int jj = 0; jj < 2; ++jj) { const v4u xw = xk[jj]; const float x[8] = {bflo(xw.x), bfhi(xw.x), bflo(xw.y), bfhi(xw.y), bflo(xw.z), bfhi(xw.z), bflo(xw.w), bfhi(xw.w)};
#pragma unroll
            for (int c = 0; c < 8; ++c) { s += x[c] * x[c]; const int slot = (8 * jj + c) * 64 + F.lane; const f32x4 w0 = *(const LAS f32x4*)(gwt + slot * 4), w1 = *(const LAS f32x4*)(gwt + 4096 + slot * 4);
                lg[0] += x[c] * w0[0]; lg[1] += x[c] * w0[1]; lg[2] += x[c] * w0[2]; lg[3] += x[c] * w0[3]; lg[4] += x[c] * w1[0]; lg[5] += x[c] * w1[1]; lg[6] += x[c] * w1[2]; lg[7] += x[c] * w1[3]; } }
        s = wave_sum(s);
        const float rs = __builtin_amdgcn_rsqf(s * (1.f / DM) + RMS_EPS);
        { unsigned char* x8r = F.ws + R_X8 + (size_t)m * DM + 8 * F.lane;
#pragma unroll
          for (int jj = 0; jj < 2; ++jj) { const v4u xw = xk[jj]; v2u w; w.x = pk4_fp8(bflo(xw.x) * rs, bfhi(xw.x) * rs, bflo(xw.y) * rs, bfhi(xw.y) * rs); w.y = pk4_fp8(bflo(xw.z) * rs, bfhi(xw.z) * rs, bflo(xw.w) * rs, bfhi(xw.w) * rs); *(v2u*)(x8r + 512 * jj) = w; } }
        { const int ln_ = pg8::lane_now(); const bool b1 = ln_ & 1, b2 = ln_ & 2, b3 = ln_ & 4; float k4[4], k2[2];
#pragma unroll
          for (int i = 0; i < 4; ++i) { const float snd = b1 ? lg[i] : lg[4 + i]; k4[i] = (b1 ? lg[4 + i] : lg[i]) + __shfl_xor(snd, 1); }
#pragma unroll
          for (int i = 0; i < 2; ++i) { const float snd = b2 ? k4[i] : k4[2 + i]; k2[i] = (b2 ? k4[2 + i] : k4[i]) + __shfl_xor(snd, 2); }
          const float snd = b3 ? k2[0] : k2[1]; float k1 = (b3 ? k2[1] : k2[0]) + __shfl_xor(snd, 4);
          k1 += __shfl_xor(k1, 8); k1 += __shfl_xor(k1, 16); k1 += __shfl_xor(k1, 32);
          if (nrow < 32) { LAS float* rr = (LAS float*)(rrow + (F.wave * 32 + nrow) * 16);
              if (F.lane < 8) rr[4 * (F.lane & 1) + 2 * ((F.lane >> 1) & 1) + ((F.lane >> 2) & 1)] = k1;
              if (F.lane == 8) { rr[8] = rs; ((LAS int*)rr)[9] = m; } } }
        ++nrow;
    }
    for (int i = F.lane; i < nrow && i < 32; i += 64) { LAS float* rr = (LAS float*)(rrow + (F.wave * 32 + i) * 16); float lg[8];
#pragma unroll
        for (int e = 0; e < 8; ++e) lg[e] = rr[e];
        const float rs = rr[8];
        int e1 = 0; float v1 = lg[0];
#pragma unroll
        for (int e = 1; e < 8; ++e) if (lg[e] > v1) { v1 = lg[e]; e1 = e; }
        int e2 = (e1 + 1) & 7; float v2 = -3.0e38f;
#pragma unroll
        for (int e = 0; e < 8; ++e) if (e != e1 && lg[e] > v2) { v2 = lg[e]; e2 = e; }
        const float g1 = 1.f / (1.f + expf((v2 - v1) * rs));
        const unsigned p1 = __hip_atomic_fetch_add(lcnt + e1, 1u, __ATOMIC_RELAXED, __HIP_MEMORY_SCOPE_WORKGROUP), p2 = __hip_atomic_fetch_add(lcnt + 8 + e2, 1u, __ATOMIC_RELAXED, __HIP_MEMORY_SCOPE_WORKGROUP);
        LAS int* ri = (LAS int*)rr; ri[0] = e1; ri[1] = e2; ri[2] = (int)p1; ri[3] = (int)p2; rr[4] = g1; }
    __syncthreads();
    if (F.tid < 16) lbase[F.tid] = atomicAdd(cnt + 64 * F.tid, lcnt[F.tid]);
    __syncthreads();
    for (int i = F.lane; i < nrow && i < 32; i += 64) { const LAS int* rr = rrow + (F.wave * 32 + i) * 16; const int m = rr[9], e1 = rr[0], e2 = rr[1]; const float g1 = ((const LAS float*)rr)[4];
        const size_t q1 = (size_t)e1 * M + lbase[e1] + (unsigned)rr[2], q2 = (size_t)(8 + e2) * M + lbase[8 + e2] + (unsigned)rr[3];
        lidx[q1] = m; lgate[q1] = g1; lidx[q2] = m; lgate[q2] = 1.f - g1; }
    __syncthreads();
    LAS float* scr = (LAS float*)(F.lds + RING_OFF + F.wave * 8448);
    constexpr int I_13 = 16 * (2 * FFE / 32), I_2 = (FFE / 64) * 32, I_E = I_13 + I_2;
    for (int it = gw; it < NEXP * I_E; it += NGW) { const int e = it / I_E; int r = it % I_E;
        if (r < I_13) { conv_up8(F.in[17] + (size_t)e * DM * FFE, F.in[18] + (size_t)e * DM * FFE, FFE, F.in[2] + DM, SW1, F.ws + R_W13E + e * SZ_W13E, r, scr, F.lane); continue; } r -= I_13;
        conv_std8(F.in[19] + (size_t)e * FFE * DM, DM, DM, SW2, F.ws + R_W2E + e * SZ_W2E, FFE, r, scr, F.lane); }
}
__device__ __forceinline__ void moe_table(const Frame& F) {
    volatile LAS int* tb = (volatile LAS int*)(F.lds + MISC_OFF + 64);
    if (F.tid < 64) {
        const int ln = pg8::lane_now(); const int c = (ln < 16) ? (int)__hip_atomic_load(F.ctl + CW_CNT + 64 * ln, RLX_AGENT) : 0; const int t = (c + 255) >> 8;
        int incl = t;
#pragma unroll
        for (int d = 1; d < 16; d <<= 1) { const int v = __shfl_up(incl, d); if (ln >= d) incl += v; }
        if (ln < 16) { tb[ln] = incl - t; tb[32 + ln] = c; }
        if (ln == 15) tb[16] = incl; }
    __syncthreads();
}
constexpr int PH_PER_LAYER = 13, N_PHASES = 1 + 2 * PH_PER_LAYER;
struct Args { const float* in[20]; float* out; unsigned char* ws; int ph_lo, ph_hi; };
__global__ void __launch_bounds__(NTHR, 2) mk_fwd(Args args) {
    extern __shared__ __attribute__((aligned(16))) unsigned char lds[];
    Frame F;
    F.lds = (LAS unsigned char*)lds; F.MISC = (volatile LAS unsigned*)(F.lds + MISC_OFF);
    F.tid = 0; F.lane = 0; F.wave = __builtin_amdgcn_readfirstlane(threadIdx.x >> 6);
    F.G = gridDim.x; { const int bx = blockIdx.x; F.vcu = (F.G % 8 == 0) ? (bx % 8) * (F.G / 8) + bx / 8 : bx; }
    F.ws = args.ws; F.ctl = (unsigned*)(args.ws + WS_CTL); F.out = args.out;
    F.in = args.in;
    for (int u = threadIdx.x; u < (LDS_BYTES - LDSCTL_OFF) / 4; u += NTHR) ((LAS unsigned*)(F.lds + LDSCTL_OFF))[u] = 0u;
    __syncthreads();
    XcdBarrier bar; bar.bar = F.ctl + CW_BAR; bar.x = 0; bar.st = nullptr;
    if (MK_N_LAUNCHES == 1) bar = xcd_barrier_post(F.ctl + CW_BAR, F.MISC + 8);
    const int lo = args.ph_lo, hi = args.ph_hi;
#define IN(k) (lo <= (k) && (k) < hi)
#define SEAM(k) do { if ((k) + 1 < hi) { if (MK_N_LAUNCHES == 1) xcd_barrier(bar); } } while (0)

    if (IN(0)) { p_prologue(F); SEAM(0); }

    for (int l = 0; l < 2; ++l) {
        const int pb = 1 + PH_PER_LAYER * l;
#define PHASE_LOCALS const Frame P = phase_frame(F); int ll = l; LAUNDER_S(ll); \
        const unsigned char* wl = P.ws + WS_W + ll * SZ_WL; bf16* x16 = (bf16*)(P.ws + WS_X16); float* ssqb = (float*)(P.ws + WS_SSQ); \
        const float* ssq_attn = ssqb + (ll == 0 ? 0 : 2 * 4 * M); float* ssq_ffn = ssqb + 4 * M; LAS float* xch = (LAS float*)(P.lds + XCH_OFF); (void)xch; LAS unsigned char* ring = P.lds + RING_OFF; const int bx = (int)blockIdx.x; \
        (void)wl; (void)x16; (void)ssq_attn; (void)ssq_ffn; (void)ring; (void)bx
        if (IN(pb + 0)) {
            PHASE_LOCALS;
            pg8::StaticOrder S; S.init(x16, wl + OFF_WA, M, NA, P.G, bx);
            EpiA E{(GAS bf16*)(P.ws + R_BUFA), (const GAS float*)ssq_attn, (const GAS float*)((const float*)(P.ws + WS_MISC) + MI_QKG + ll * 256), P.lds + SSQL_OFF};
            pg8::gemm_phase<DM>(ring, S, E, P.wave); SEAM(pb + 0); }
                if (IN(pb + 1)) { p_attn_mfma(F); p_conv(F, l); SEAM(pb + 1); }
        if (IN(pb + 2)) {
            PHASE_LOCALS;
            pg8::StaticOrder S; S.init(x16, wl + OFF_WC, M, NC, P.G, bx);
            const float* misc = (const float*)(P.ws + WS_MISC);
            EpiC E{(GAS bf16*)(P.ws + R_HG), (const GAS float*)ssq_attn, (const GAS float*)(misc + MI_LBA + ll * 768), P.lds + SSQL_OFF};
            pg8::gemm_phase<DM>(ring, S, E, P.wave); SEAM(pb + 2); }
        if (IN(pb + 3)) { p_hgrn1_mfma(F); SEAM(pb + 3); }
        if (IN(pb + 4)) { p_hgrn2_mfma(F, l); SEAM(pb + 4); }
        if (IN(pb + 6)) {
            { PHASE_LOCALS;
              pg8::GateOrder SG; SG.mo.init(P.ws + R_MIX, wl + OFF_WP, M, DM, P.G, bx); SG.A = (const char*)x16; SG.Bt = (const char*)(wl + OFF_WG);
              EpiG EG{(GAS unsigned char*)(P.ws + R_GATES), (const GAS float*)ssq_attn, P.lds + SSQL_OFF};
              pg8::gemm_phase<DM>(ring, SG, EG, P.wave); }
            { PHASE_LOCALS;
              pg8::StaticOrder S; S.init(P.ws + R_MIX, wl + OFF_WP, M, DM, P.G, bx);
              EpiM E{(GAS bf16*)(P.ws + R_MERGED), (const GAS unsigned char*)(P.ws + R_GATES)};
              pg8::gemm_phase<KP>(ring, S, E, P.wave); }
            SEAM(pb + 6); }
        if (IN(pb + 7)) {
            PHASE_LOCALS;
            pg8::StaticOrder S; S.init(P.ws + R_MERGED, wl + OFF_WO, M, DM, P.G, bx);
            EpiO E{(GAS bf16*)x16, (GAS float*)ssq_ffn, xch};
            pg8::gemm_phase<DM>(ring, S, E, P.wave); SEAM(pb + 7); }
        if (l == 0) {
            if (IN(pb + 8)) {
                PHASE_LOCALS;
                pg8::StaticOrder S; S.init(x16, P.ws + WS_W13, M, 2 * FFD, P.G, bx);
                EpiU E{(GAS bf16*)(P.ws + R_HID), (const GAS float*)ssq_ffn, P.lds + SSQL_OFF};
                pg8::gemm_phase<DM>(ring, S, E, P.wave); SEAM(pb + 8); }
            if (IN(pb + 9)) {
                PHASE_LOCALS;
                pg8::StaticOrder S; S.init(P.ws + R_HID, P.ws + WS_W2, M, DM, P.G, bx);
                EpiO E{(GAS bf16*)x16, (GAS float*)(ssqb + 2 * 4 * M), xch};
                pg8::gemm_phase<FFD>(ring, S, E, P.wave); SEAM(pb + 9); }
        } else {
            if (IN(pb + 8)) { p_route(F); SEAM(pb + 8); }
            if (IN(pb + 9)) {
                PHASE_LOCALS;
                volatile LAS int* tb = (volatile LAS int*)(P.lds + MISC_OFF + 64);
                const int* lidx = (const int*)(P.ws + R_LIST);
                moe_table(P);
                MoeUpOrder S; S.A = (const char*)(P.ws + R_X8); S.Bt = (const char*)(P.ws + R_W13E); S.bstride = SZ_W13E; S.idx = lidx; S.tb = tb; S.nN = 2 * FFE / 256; S.ubase = 0; S.nwg = tb[16] * S.nN; S.lim = S.nwg; S.G = P.G; S.c = bx;
                EpiMU E{(GAS unsigned char*)(P.ws + R_HIDE), tb};
                pg8::gemm_phase<DM, EpiMU, MoeUpOrder, DM, true>(ring, S, E, P.wave); SEAM(pb + 9); }
#pragma unroll 1
            for (int slot = 0; slot < 2; ++slot) {
                if (IN(pb + 10 + slot)) {
                    PHASE_LOCALS; int sl = slot; LAUNDER_S(sl);
                    volatile LAS int* tb = (volatile LAS int*)(P.lds + MISC_OFF + 64);
                    const int* lidx = (const int*)(P.ws + R_LIST); const float* lgate = (const float*)(P.ws + R_LIST) + 16 * M;
                    moe_table(P);
                    MoeDownOrder S; S.A = (const char*)(P.ws + R_HIDE); S.Bt = (const char*)(P.ws + R_W2E); S.bstride = SZ_W2E; S.idx = nullptr; S.tb = tb; S.nN = DM / 256; S.ubase = tb[8 * sl] * S.nN; S.nwg = (tb[8 * sl + 8] - tb[8 * sl]) * S.nN; S.G = P.G; S.c = bx;
                    S.lim = S.nwg;
                    EpiMD E{(GAS bf16*)x16, (sl == 0) ? (GAS float*)nullptr : (GAS float*)P.out, (const GAS int*)lidx, (const GAS float*)lgate, tb, P.lds + SSQL_OFF};
                    pg8::gemm_phase<FFE, EpiMD, MoeDownOrder, FFE, true>(ring, S, E, P.wave);
                    if (sl == 0) SEAM(pb + 10 + slot); }
            }
        }
    }
#undef IN
#undef SEAM
}


extern "C" void kernel_launch(void* const* d_in, const int* in_sizes, int n_in, void* d_out, int out_size, void* d_ws, size_t ws_size, hipStream_t stream) {
    static int grid = 0;
    if (grid == 0) {
        if (n_in != 20 || in_sizes[0] != M * DM || out_size != M * DM || ws_size < WS_TOTAL) { fprintf(stderr, "kernel_launch: unexpected shapes / workspace (%d inputs, in0 %d, out %d, ws %zu, need %zu); nothing launched\n", n_in, n_in > 0 ? in_sizes[0] : -1, out_size, ws_size, (size_t)WS_TOTAL); grid = -1; return; }
        int dev = 0, cus = 0, per_cu = 0;
        if (hipGetDevice(&dev) != hipSuccess || hipDeviceGetAttribute(&cus, hipDeviceAttributeMultiprocessorCount, dev) != hipSuccess) { grid = -1; return; }
        if (hipFuncSetAttribute((const void*)mk_fwd, hipFuncAttributeMaxDynamicSharedMemorySize, LDS_BYTES) != hipSuccess) { fprintf(stderr, "kernel_launch: hipFuncSetAttribute failed\n"); grid = -1; return; }
        if (hipOccupancyMaxActiveBlocksPerMultiprocessor(&per_cu, (const void*)mk_fwd, NTHR, LDS_BYTES) != hipSuccess || per_cu < 1) { fprintf(stderr, "kernel_launch: occupancy query reports %d workgroups per CU\n", per_cu); }
        (void)hipGetLastError();
        grid = cus;
    }
    if (grid < 0) return;
    if (hipMemsetAsync((char*)d_ws + WS_CTL, 0, CTL_ZERO_BYTES, stream) != hipSuccess) return;
    Args a{};
    for (int i = 0; i < 20; ++i) a.in[i] = (const float*)d_in[i];
    a.out = (float*)d_out; a.ws = (unsigned char*)d_ws;
#if MK_N_LAUNCHES == 1
    a.ph_lo = 0; a.ph_hi = N_PHASES;
    hipLaunchKernelGGL(mk_fwd, dim3(grid), dim3(NTHR), LDS_BYTES, stream, a);
#else
    for (int p = 0; p < N_PHASES; ++p) {
        if (p >= 1 + 10 && p < 1 + PH_PER_LAYER) continue;
        a.ph_lo = p; a.ph_hi = p + 1;
        hipLaunchKernelGGL(mk_fwd, dim3(grid), dim3(NTHR), LDS_BYTES, stream, a);
    }
#endif
}
```
